# Optimizing an MI355X kernel written in HIP

```python
import math
import jax, jax.numpy as jnp
from jax import lax
import numpy as np

D_MODEL = 1024
BATCH = 2
SEQ = 16384
DEPTH = 2

ATT_HEADS = 8
ATT_KV_GROUPS = 2
ATT_HPG = ATT_HEADS // ATT_KV_GROUPS
HEAD_DIM = 64
D_ATT = ATT_HEADS * HEAD_DIM
D_KV = ATT_KV_GROUPS * HEAD_DIM
N_BRANCH = 3
CMP_LEN = 32
CMP_STRIDE = 16
CMP_HIDDEN = 256
SLC_BLOCK = 64
SLC_TOPN = 16
WINDOW = 512
Q_BLOCK = 128
SEL_FORCE = 1.0e4
REL_BUCKETS = 32
REL_MAX_DIST = 128
GMLP_GROUPS = 4
GMLP_GROUP_DIM = 64
D_GMLP = GMLP_GROUPS * GMLP_GROUP_DIM
GMLP_CHUNK = 128
SSM_HEADS = 4
SSM_HEAD_DIM = 64
D_SSM = SSM_HEADS * SSM_HEAD_DIM
SSM_GROUPS = 2
SSM_STATE = 128
SSM_CONV = 4
SSM_CHUNK = 256
D_XBC = D_SSM + 2 * SSM_GROUPS * SSM_STATE
D_MIX = D_ATT + D_GMLP + D_SSM
D_ATT_IN = D_ATT + 6 * D_KV + ATT_HEADS * N_BRANCH
D_GMLP_IN = 2 * D_GMLP
D_SSM_IN = D_SSM + D_XBC + SSM_HEADS
D_IN = D_ATT_IN + D_GMLP_IN + D_SSM_IN
D_FF = 2816
N_SUB = 3
ALPHA = (2 * DEPTH) ** 0.25
BETA = (8 * DEPTH) ** -0.25
LN_EPS = 1e-5

kernel_name = "hybrid_nsa_gmlp_ssd_macaron_deepnorm"


def layer_norm(x, g, b):
    xf = x.astype(jnp.float32)
    mu = xf.mean(-1, keepdims=True)
    var = jnp.square(xf - mu).mean(-1, keepdims=True)
    return ((xf - mu) * lax.rsqrt(var + LN_EPS)).astype(x.dtype) * g + b


def swiglu(h, w1, w3, w2):
    return (jax.nn.silu(h @ w1) * (h @ w3)) @ w2


def masked_softmax(s, mask):
    s = jnp.where(mask, s.astype(jnp.float32), -jnp.inf)
    m = jnp.max(s, axis=-1, keepdims=True)
    m = jnp.where(jnp.isfinite(m), m, 0.0)
    p = jnp.exp(s - m)
    return p / jnp.maximum(p.sum(-1, keepdims=True), 1e-30)


def rel_bucket(dist):
    n = jnp.maximum(dist, 0)
    max_exact = REL_BUCKETS // 2
    nf = jnp.maximum(n, 1).astype(jnp.float32)
    large = max_exact + (jnp.log(nf / max_exact) / math.log(REL_MAX_DIST / max_exact)
                         * (REL_BUCKETS - max_exact)).astype(jnp.int32)
    large = jnp.minimum(large, REL_BUCKETS - 1)
    return jnp.where(n < max_exact, n, large)


def nsa_attention(q, k_cmp, v_cmp, k_slc, v_slc, k_win, v_win, gates, rel_bias,
                  cmp_pe, cmp_w1, cmp_b1, cmp_w2):
    Bn, T = q.shape[:2]
    G, I, Dh = ATT_KV_GROUPS, ATT_HPG, HEAD_DIM
    n_cmp = (T - CMP_LEN) // CMP_STRIDE + 1
    n_slc = T // SLC_BLOCK
    n_qb = T // Q_BLOCK
    top_n = min(SLC_TOPN, n_slc)
    kw_len = Q_BLOCK + WINDOW

    cmp_start = np.arange(n_cmp) * CMP_STRIDE
    blk_idx = cmp_start[:, None] + np.arange(CMP_LEN)[None, :]

    def compress(kv, j):
        blocks = kv[:, blk_idx] + cmp_pe[j][None, None, :, None, :]
        blocks = blocks.transpose(0, 3, 1, 2, 4).reshape(Bn, G, n_cmp, CMP_LEN * Dh)
        return jax.nn.gelu(blocks @ cmp_w1[j] + cmp_b1[j]) @ cmp_w2[j]

    kc, vc = compress(k_cmp, 0), compress(v_cmp, 1)
    cmp_end = jnp.asarray(cmp_start + CMP_LEN - 1, jnp.int32)
    slc_start = np.arange(n_slc) * SLC_BLOCK
    overlap = np.clip(np.minimum(cmp_start[:, None] + CMP_LEN, slc_start[None, :] + SLC_BLOCK)
                      - np.maximum(cmp_start[:, None], slc_start[None, :]), 0, None)
    overlap = jnp.asarray(overlap / CMP_LEN, jnp.float32)

    ks = k_slc.transpose(0, 2, 1, 3).reshape(Bn, G, n_slc, SLC_BLOCK, Dh)
    vs = v_slc.transpose(0, 2, 1, 3).reshape(Bn, G, n_slc, SLC_BLOCK, Dh)
    pad_w = ((0, 0), (0, 0), (WINDOW, 0), (0, 0))
    kw = jnp.pad(k_win.transpose(0, 2, 1, 3), pad_w)
    vw = jnp.pad(v_win.transpose(0, 2, 1, 3), pad_w)

    win_dist = np.arange(Q_BLOCK)[:, None] + WINDOW - np.arange(kw_len)[None, :]
    win_mask = jnp.asarray((win_dist >= 0) & (win_dist < WINDOW))
    win_bias = rel_bias[rel_bucket(jnp.asarray(win_dist, jnp.int32))]
    win_bias = win_bias.reshape(Q_BLOCK, kw_len, G, I).transpose(2, 3, 0, 1)
    rb = rel_bias.reshape(REL_BUCKETS, G, I)
    gather_blocks = jax.vmap(jax.vmap(lambda kb, s: kb[s]))
    bias_by_group = jax.vmap(lambda tb, bk: tb[bk], in_axes=(1, 1), out_axes=1)

    qb_all = q.reshape(Bn, n_qb, Q_BLOCK, G, I, Dh).transpose(1, 0, 3, 4, 2, 5) * (Dh ** -0.5)
    gb_all = gates.reshape(Bn, n_qb, Q_BLOCK, G, I, N_BRANCH).transpose(1, 0, 3, 4, 2, 5)

    def block(args):
        b_idx, qb, gb = args
        start = b_idx * Q_BLOCK
        t = start + jnp.arange(Q_BLOCK, dtype=jnp.int32)
        dist_c = t[:, None] - cmp_end[None, :]
        bias_c = rel_bias[rel_bucket(dist_c)].reshape(Q_BLOCK, n_cmp, G, I).transpose(2, 3, 0, 1)
        p_c = masked_softmax(jnp.einsum('bgiqd,bgkd->bgiqk', qb, kc) + bias_c, dist_c >= 0)
        o_c = jnp.einsum('bgiqk,bgkd->bgiqd', p_c.astype(vc.dtype), vc)
        imp = jnp.einsum('bgiqk,kn->bgqn', p_c, overlap)
        cur = (t // SLC_BLOCK)[:, None]
        blk = jnp.arange(n_slc, dtype=jnp.int32)[None, :]
        forced = (blk == 0) | (blk == cur) | (blk == cur - 1)
        imp = jnp.where(forced, SEL_FORCE, jnp.where(blk <= cur, imp, -SEL_FORCE))
        _, sel = lax.top_k(imp, top_n)
        k_sel = gather_blocks(ks, sel).reshape(Bn, G, Q_BLOCK, top_n * SLC_BLOCK, Dh)
        v_sel = gather_blocks(vs, sel).reshape(Bn, G, Q_BLOCK, top_n * SLC_BLOCK, Dh)
        pos_sel = (sel[..., None] * SLC_BLOCK + jnp.arange(SLC_BLOCK, dtype=jnp.int32)
                   ).reshape(Bn, G, Q_BLOCK, top_n * SLC_BLOCK)
        dist_s = t[None, None, :, None] - pos_sel
        bias_s = bias_by_group(rb, rel_bucket(dist_s)).transpose(0, 1, 4, 2, 3)
        p_s = masked_softmax(jnp.einsum('bgiqd,bgqkd->bgiqk', qb, k_sel) + bias_s,
                             (dist_s >= 0)[:, :, None])
        o_s = jnp.einsum('bgiqk,bgqkd->bgiqd', p_s.astype(v_sel.dtype), v_sel)
        kb = lax.dynamic_slice_in_dim(kw, start, kw_len, axis=2)
        vb = lax.dynamic_slice_in_dim(vw, start, kw_len, axis=2)
        pos_w = start - WINDOW + jnp.arange(kw_len, dtype=jnp.int32)
        p_w = masked_softmax(jnp.einsum('bgiqd,bgkd->bgiqk', qb, kb) + win_bias,
                             win_mask & (pos_w >= 0)[None, :])
        o_w = jnp.einsum('bgiqk,bgkd->bgiqd', p_w.astype(vb.dtype), vb)
        return gb[..., 0:1] * o_c + gb[..., 1:2] * o_s + gb[..., 2:3] * o_w

    o = lax.map(block, (jnp.arange(n_qb, dtype=jnp.int32), qb_all, gb_all))
    return o.transpose(1, 0, 4, 2, 3, 5).reshape(Bn, T, ATT_HEADS * Dh)


def gmlp_spatial_gating(uv, ln_g, ln_b, ws, bs):
    Bn, T, _ = uv.shape
    u, v = jnp.split(jax.nn.gelu(uv), 2, axis=-1)
    v = layer_norm(v, ln_g, ln_b)
    v = v.reshape(Bn, T // GMLP_CHUNK, GMLP_CHUNK, GMLP_GROUPS, GMLP_GROUP_DIM)
    causal = jnp.tril(jnp.ones((GMLP_CHUNK, GMLP_CHUNK), dtype=bool))
    w = jnp.where(causal[None], ws, 0.0)
    sv = jnp.einsum('gts,bcsgd->bctgd', w, v) + bs.T[None, None, :, :, None]
    return u * sv.reshape(Bn, T, D_GMLP)


def segsum(a):
    L = a.shape[-1]
    cs = jnp.cumsum(a, axis=-1)
    mask = jnp.tril(jnp.ones((L, L), dtype=bool))
    return jnp.where(mask, cs[..., :, None] - cs[..., None, :], -jnp.inf)


def ssd_chunked(X, A, Bh, Ch):
    Bn, T, H, P = X.shape
    nc = -(-T // SSM_CHUNK)
    pad = nc * SSM_CHUNK - T
    def chunk(a):
        a = jnp.pad(a, [(0, 0), (0, pad)] + [(0, 0)] * (a.ndim - 2))
        return a.reshape(Bn, nc, SSM_CHUNK, *a.shape[2:])
    X, A, Bh, Ch = chunk(X), chunk(A), chunk(Bh), chunk(Ch)
    A = A.transpose(0, 3, 1, 2)
    A_cs = jnp.cumsum(A, axis=-1)
    Lmat = jnp.exp(segsum(A))
    scores = jnp.einsum('bclhn,bcshn->bhcls', Ch, Bh) * Lmat
    y_diag = jnp.einsum('bhcls,bcshp->bclhp', scores, X)
    decay = jnp.exp(A_cs[..., -1:] - A_cs)
    states = jnp.einsum('bclhn,bhcl,bclhp->bchpn', Bh, decay, X)
    chunk_decay = jnp.exp(A_cs[..., -1])

    def step(h, inp):
        s_c, dec = inp
        return dec[:, :, None, None] * h + s_c, h

    h0 = jnp.zeros((Bn, H, P, Bh.shape[-1]), X.dtype)
    _, prev = lax.scan(step, h0, (states.transpose(1, 0, 2, 3, 4), chunk_decay.transpose(2, 0, 1)))
    prev = prev.transpose(1, 0, 2, 3, 4)
    y_off = jnp.einsum('bclhn,bchpn,bhcl->bclhp', Ch, prev, jnp.exp(A_cs))
    return (y_diag + y_off).reshape(Bn, nc * SSM_CHUNK, H, P)[:, :T]


def mamba2_ssd(zxbcdt, conv_w, conv_b, dt_bias, a_log, d_skip, norm_g):
    Bn, T, _ = zxbcdt.shape
    z, xbc, dt = jnp.split(zxbcdt, [D_SSM, D_SSM + D_XBC], axis=-1)
    xbc = lax.conv_general_dilated(xbc, conv_w[:, None, :], window_strides=(1,),
                                   padding=[(SSM_CONV - 1, 0)],
                                   dimension_numbers=('NWC', 'WIO', 'NWC'),
                                   feature_group_count=D_XBC) + conv_b
    xbc = jax.nn.silu(xbc)
    xs, Bm, Cm = jnp.split(xbc, [D_SSM, D_SSM + SSM_GROUPS * SSM_STATE], axis=-1)
    dt = jax.nn.softplus((dt + dt_bias).astype(jnp.float32))
    A = -jnp.exp(a_log.astype(jnp.float32))
    X = xs.reshape(Bn, T, SSM_HEADS, SSM_HEAD_DIM)
    rep = SSM_HEADS // SSM_GROUPS
    Bh = jnp.repeat(Bm.reshape(Bn, T, SSM_GROUPS, SSM_STATE), rep, axis=2).astype(jnp.float32)
    Ch = jnp.repeat(Cm.reshape(Bn, T, SSM_GROUPS, SSM_STATE), rep, axis=2).astype(jnp.float32)
    y = ssd_chunked(X.astype(jnp.float32) * dt[..., None], A * dt, Bh, Ch)
    y = y + X.astype(jnp.float32) * d_skip.astype(jnp.float32)[:, None]
    g = (y.reshape(Bn, T, D_SSM) * jax.nn.silu(z.astype(jnp.float32))).reshape(Bn, T, SSM_GROUPS, -1)
    g = g * lax.rsqrt(jnp.mean(jnp.square(g), axis=-1, keepdims=True) + LN_EPS)
    return g.reshape(Bn, T, D_SSM).astype(zxbcdt.dtype) * norm_g


def hybrid_mixer(h, rel_bias, w_in, w_out, cmp_pe, cmp_w1, cmp_b1, cmp_w2,
                 gmlp_ln_g, gmlp_ln_b, gmlp_ws, gmlp_bs,
                 conv_w, conv_b, dt_bias, a_log, d_skip, norm_g):
    Bn, T, _ = h.shape
    proj = h @ w_in
    att_in, gmlp_in, ssm_in = jnp.split(proj, [D_ATT_IN, D_ATT_IN + D_GMLP_IN], axis=-1)
    cuts = [D_ATT + i * D_KV for i in range(7)]
    q, kc, vc, ks, vs, kw, vw, g = jnp.split(att_in, cuts, axis=-1)
    kvr = lambda a: a.reshape(Bn, T, ATT_KV_GROUPS, HEAD_DIM)
    gates = jax.nn.sigmoid(g).reshape(Bn, T, ATT_HEADS, N_BRANCH)
    o_att = nsa_attention(q.reshape(Bn, T, ATT_HEADS, HEAD_DIM), kvr(kc), kvr(vc), kvr(ks), kvr(vs),
                          kvr(kw), kvr(vw), gates, rel_bias, cmp_pe, cmp_w1, cmp_b1, cmp_w2)
    o_gmlp = gmlp_spatial_gating(gmlp_in, gmlp_ln_g, gmlp_ln_b, gmlp_ws, gmlp_bs)
    o_ssm = mamba2_ssd(ssm_in, conv_w, conv_b, dt_bias, a_log, d_skip, norm_g)
    return jnp.concatenate([o_att, o_gmlp, o_ssm], axis=-1) @ w_out


def post_norm_residual(x, y, gate, weight, g, b):
    return layer_norm(ALPHA * x + weight * (1.0 + gate) * y, g, b)


def setup_inputs(seed: int = 0) -> dict:
    key = jax.random.key(seed)
    k = jax.random.split(key, 30)
    nrm = lambda kk, shape, s: jax.random.normal(kk, shape, jnp.float32) * s
    L = DEPTH
    dt_init = jnp.exp(jax.random.uniform(k[25], (L, SSM_HEADS), jnp.float32,
                                         math.log(1e-3), math.log(1e-1)))
    return {
        "x": nrm(k[0], (BATCH, SEQ, D_MODEL), 1.0),
        "c": nrm(k[1], (BATCH, D_MODEL), 1.0),
        "rel_bias": nrm(k[2], (REL_BUCKETS, ATT_HEADS), 0.5),
        "ada_w": nrm(k[3], (L, D_MODEL, N_SUB * 3 * D_MODEL), 0.5 * D_MODEL ** -0.5),
        "ada_b": nrm(k[4], (L, N_SUB * 3 * D_MODEL), 0.02),
        "ln_g": 1.0 + nrm(k[5], (L, N_SUB, D_MODEL), 0.02),
        "ln_b": nrm(k[6], (L, N_SUB, D_MODEL), 0.02),
        "ffn_w1": nrm(k[7], (L, 2, D_MODEL, D_FF), BETA * D_MODEL ** -0.5),
        "ffn_w3": nrm(k[8], (L, 2, D_MODEL, D_FF), BETA * D_MODEL ** -0.5),
        "ffn_w2": nrm(k[9], (L, 2, D_FF, D_MODEL), BETA * D_FF ** -0.5),
        "w_in": nrm(k[10], (L, D_MODEL, D_IN), D_MODEL ** -0.5),
        "w_out": nrm(k[11], (L, D_MIX, D_MODEL), BETA * D_MIX ** -0.5),
        "cmp_pe": nrm(k[12], (L, 2, CMP_LEN, HEAD_DIM), 0.1),
        "cmp_w1": nrm(k[13], (L, 2, CMP_LEN * HEAD_DIM, CMP_HIDDEN), (CMP_LEN * HEAD_DIM) ** -0.5),
        "cmp_b1": nrm(k[14], (L, 2, CMP_HIDDEN), 0.02),
        "cmp_w2": nrm(k[15], (L, 2, CMP_HIDDEN, HEAD_DIM), 1.5 * CMP_HIDDEN ** -0.5),
        "gmlp_ln_g": 1.0 + nrm(k[16], (L, D_GMLP), 0.02),
        "gmlp_ln_b": nrm(k[17], (L, D_GMLP), 0.02),
        "gmlp_ws": nrm(k[18], (L, GMLP_GROUPS, GMLP_CHUNK, GMLP_CHUNK), GMLP_CHUNK ** -0.5),
        "gmlp_bs": 1.0 + nrm(k[19], (L, GMLP_GROUPS, GMLP_CHUNK), 0.02),
        "ssm_conv_w": nrm(k[20], (L, SSM_CONV, D_XBC), SSM_CONV ** -0.5),
        "ssm_conv_b": nrm(k[21], (L, D_XBC), 0.02),
        "ssm_dt_bias": dt_init + jnp.log(-jnp.expm1(-dt_init)),
        "ssm_a_log": jnp.log(jax.random.uniform(k[22], (L, SSM_HEADS), jnp.float32, 1.0, 16.0)),
        "ssm_d": 1.0 + nrm(k[23], (L, SSM_HEADS), 0.02),
        "ssm_norm_g": 1.0 + nrm(k[24], (L, D_SSM), 0.02),
    }


def reference(x, c, rel_bias, ada_w, ada_b, ln_g, ln_b, ffn_w1, ffn_w3, ffn_w2, w_in, w_out,
              cmp_pe, cmp_w1, cmp_b1, cmp_w2, gmlp_ln_g, gmlp_ln_b, gmlp_ws, gmlp_bs,
              ssm_conv_w, ssm_conv_b, ssm_dt_bias, ssm_a_log, ssm_d, ssm_norm_g):
    Bn = x.shape[0]
    for l in range(DEPTH):
        mod = (jax.nn.silu(c) @ ada_w[l] + ada_b[l]).reshape(Bn, N_SUB, 3, D_MODEL)
        shift, scale, gate = mod[:, :, 0, None], mod[:, :, 1, None], mod[:, :, 2, None]
        h = x * (1.0 + scale[:, 0]) + shift[:, 0]
        y = swiglu(h, ffn_w1[l, 0], ffn_w3[l, 0], ffn_w2[l, 0])
        x = post_norm_residual(x, y, gate[:, 0], 0.5, ln_g[l, 0], ln_b[l, 0])
        h = x * (1.0 + scale[:, 1]) + shift[:, 1]
        y = hybrid_mixer(h, rel_bias, w_in[l], w_out[l], cmp_pe[l], cmp_w1[l], cmp_b1[l], cmp_w2[l],
                         gmlp_ln_g[l], gmlp_ln_b[l], gmlp_ws[l], gmlp_bs[l],
                         ssm_conv_w[l], ssm_conv_b[l], ssm_dt_bias[l], ssm_a_log[l], ssm_d[l],
                         ssm_norm_g[l])
        x = post_norm_residual(x, y, gate[:, 1], 1.0, ln_g[l, 1], ln_b[l, 1])
        h = x * (1.0 + scale[:, 2]) + shift[:, 2]
        y = swiglu(h, ffn_w1[l, 1], ffn_w3[l, 1], ffn_w2[l, 1])
        x = post_norm_residual(x, y, gate[:, 2], 0.5, ln_g[l, 2], ln_b[l, 2])
    return x
```

```cpp
#include <hip/hip_runtime.h>
#include <hip/hip_cooperative_groups.h>
#include <cstdio>
#include <cstdint>
namespace cg = cooperative_groups;

#ifndef EN_GMLP
#define EN_GMLP 1
#endif
#ifndef EN_SSD
#define EN_SSD 1
#endif
#ifndef EN_CMP
#define EN_CMP 1
#endif
#ifndef EN_SEL
#define EN_SEL 1
#endif
#ifndef EN_WIN
#define EN_WIN 1
#endif
#ifndef REP_MASK
#define REP_MASK 0
#endif
#ifndef EN_MIXER
#define EN_MIXER 1
#endif

#define LAS __attribute__((address_space(3)))
#define DPP_ROR(x, n) __builtin_amdgcn_update_dpp(0, (int)(x), 0x120 + (n), 0xF, 0xF, true)
typedef unsigned short bf16_t;
typedef short bf16x8 __attribute__((ext_vector_type(8)));
typedef short bf16x4 __attribute__((ext_vector_type(4)));
typedef float f32x4 __attribute__((ext_vector_type(4)));
typedef float f32x2 __attribute__((ext_vector_type(2)));
typedef unsigned u32x4 __attribute__((ext_vector_type(4)));
typedef unsigned u32x2 __attribute__((ext_vector_type(2)));

constexpr int D = 1024, NBATCH = 2, T = 16384, NT = NBATCH * T, FF = 2816, FF2 = 2 * FF, DINP = 3072, DIN = 2844;
constexpr int MODW = 9216;
constexpr float ALPHA = 1.41421356237309515f;
constexpr float LN_EPS = 1e-5f;
constexpr float LOG2E = 1.4426950408889634f;
constexpr int NWAVES = 8, NTHREADS = 512;
constexpr int LDS_BYTES = 155648;
constexpr int LDS_LUT = 147456;

constexpr size_t MiB = 1u << 20;
constexpr size_t WS_MOD = 0;
constexpr size_t WS_PEB = 512 * 1024;
constexpr size_t WS_CSL = 768 * 1024;
constexpr size_t WS_BAR = 896 * 1024;
constexpr size_t WS_W13 = 1 * MiB;
constexpr size_t WS_W2 = 45 * MiB;
constexpr size_t WS_WIN = 67 * MiB;
constexpr size_t WS_WOUT = 79 * MiB;
constexpr size_t WS_CW1 = 83 * MiB;
constexpr size_t WS_GW = 87 * MiB;
constexpr size_t WS_H = 88 * MiB;
constexpr size_t WS_U = 152 * MiB;
constexpr int PP = 3072;
constexpr int PC_Q = 0, PC_KC = 512, PC_VC = 640, PC_KS = 768, PC_VS = 896, PC_KW = 1024, PC_VW = 1152, PC_U = 1280, PC_V = 1536, PC_Z = 1792, PC_X = 2048, PC_B = 2304, PC_C = 2560;
constexpr size_t WS_MISC = WS_U + 192 * MiB;
constexpr size_t WS_HID = WS_MISC;
constexpr size_t WS_KCMP = WS_MISC + 4 * MiB;
constexpr size_t WS_VCMPT = WS_KCMP + 512 * 1024;
constexpr size_t WS_GATES = WS_MISC + 5 * MiB;
constexpr size_t WS_DT = WS_MISC + 8 * MiB;
constexpr size_t WS_CS = WS_DT + 512 * 1024;
constexpr size_t WS_STATES = WS_MISC + 9 * MiB;
constexpr size_t WS_PREV = WS_MISC + 25 * MiB;
constexpr size_t WS_VST = WS_MISC + 33 * MiB;
constexpr size_t WS_VWT = WS_MISC + 41 * MiB;
constexpr size_t WS_KSF = WS_MISC + 49 * MiB;
constexpr size_t WS_KWF = WS_MISC + 57 * MiB;
constexpr size_t WS_Y = WS_MISC + 65 * MiB;
constexpr size_t WS_END = WS_MISC + 129 * MiB;

struct Params {
    const float* in[26];
    float* out;
    unsigned char* ws;
};

__device__ __forceinline__ unsigned pk2(float lo, float hi) { unsigned r; asm("v_cvt_pk_bf16_f32 %0, %1, %2" : "=v"(r) : "v"(lo), "v"(hi)); return r; }
__device__ __forceinline__ unsigned f2bf(float f) { return pk2(f, 0.f) & 0xffffu; }
__device__ __forceinline__ float bf2f(unsigned short b) { return __builtin_bit_cast(float, ((unsigned)b) << 16); }
__device__ __forceinline__ u32x2 pk4(f32x4 v) { u32x2 r; r.x = pk2(v.x, v.y); r.y = pk2(v.z, v.w); return r; }
__device__ __forceinline__ float silu_f(float x) { return x * __builtin_amdgcn_rcpf(1.f + __builtin_amdgcn_exp2f(-LOG2E * x)); }
__device__ __forceinline__ float sigmoid_f(float x) { return __builtin_amdgcn_rcpf(1.f + __builtin_amdgcn_exp2f(-LOG2E * x)); }
__device__ __forceinline__ float gelu_tanh(float x) {
    const float y = 0.7978845608028654f * (x + 0.044715f * x * x * x); return x * __builtin_amdgcn_rcpf(1.f + __builtin_amdgcn_exp2f(-2.f * LOG2E * y)); }
__device__ __forceinline__ float softplus_f(float x) { return fmaxf(x, 0.f) + log1pf(__expf(-fabsf(x))); }
__device__ __forceinline__ float wave_sum(float v) {
#pragma unroll
    for (int o = 1; o < 64; o <<= 1) v += __shfl_xor(v, o);
    return v;
}
__device__ __forceinline__ void swap16(unsigned& a, unsigned& b) { asm volatile("s_nop 1\n\tv_permlane16_swap_b32 %0, %1\n\ts_nop 1" : "+v"(a), "+v"(b)); }
__device__ __forceinline__ void swap32(unsigned& a, unsigned& b) { asm volatile("s_nop 1\n\tv_permlane32_swap_b32 %0, %1\n\ts_nop 1" : "+v"(a), "+v"(b)); }
__device__ __forceinline__ float qmax(float v) {
    unsigned a = __builtin_bit_cast(unsigned, v), b = a; swap16(a, b); v = fmaxf(__builtin_bit_cast(float, a), __builtin_bit_cast(float, b));
    a = __builtin_bit_cast(unsigned, v); b = a; swap32(a, b); return fmaxf(__builtin_bit_cast(float, a), __builtin_bit_cast(float, b)); }
__device__ __forceinline__ float qsum(float v) {
    unsigned a = __builtin_bit_cast(unsigned, v), b = a; swap16(a, b); v = __builtin_bit_cast(float, a) + __builtin_bit_cast(float, b);
    a = __builtin_bit_cast(unsigned, v); b = a; swap32(a, b); return __builtin_bit_cast(float, a) + __builtin_bit_cast(float, b); }
__device__ __forceinline__ float wave_fsum(float v) {
    v += __builtin_bit_cast(float, __builtin_amdgcn_update_dpp(0, __builtin_bit_cast(int, v), 0xB1, 0xF, 0xF, true));
    v += __builtin_bit_cast(float, __builtin_amdgcn_update_dpp(0, __builtin_bit_cast(int, v), 0x4E, 0xF, 0xF, true));
    v += __builtin_bit_cast(float, __builtin_amdgcn_update_dpp(0, __builtin_bit_cast(int, v), 0x141, 0xF, 0xF, true));
    v += __builtin_bit_cast(float, __builtin_amdgcn_update_dpp(0, __builtin_bit_cast(int, v), 0x140, 0xF, 0xF, true));
    return qsum(v); }
__device__ __forceinline__ unsigned wave_umax(unsigned v) {
    v = max(v, (unsigned)__builtin_amdgcn_update_dpp(0, (int)v, 0xB1, 0xF, 0xF, true));
    v = max(v, (unsigned)__builtin_amdgcn_update_dpp(0, (int)v, 0x4E, 0xF, 0xF, true));
    v = max(v, (unsigned)__builtin_amdgcn_update_dpp(0, (int)v, 0x141, 0xF, 0xF, true));
    v = max(v, (unsigned)__builtin_amdgcn_update_dpp(0, (int)v, 0x140, 0xF, 0xF, true));
    unsigned a = v, b = v; swap16(a, b); v = max(a, b); a = v; b = v; swap32(a, b); return max(a, b); }
#define WAVE_SYNC() do { asm volatile("s_waitcnt lgkmcnt(0)" ::: "memory"); __builtin_amdgcn_wave_barrier(); } while (0)
__device__ __forceinline__ unsigned pk_fp8x4(float a, float b, float c, float d) { int r = __builtin_amdgcn_cvt_pk_fp8_f32(a, b, 0, false); r = __builtin_amdgcn_cvt_pk_fp8_f32(c, d, r, true); return (unsigned)r; }
__device__ __forceinline__ u32x2 bf8_to_fp8(bf16x8 v, float sc) { u32x2 r;
    r.x = pk_fp8x4(bf2f((unsigned short)v[0]) * sc, bf2f((unsigned short)v[1]) * sc, bf2f((unsigned short)v[2]) * sc, bf2f((unsigned short)v[3]) * sc);
    r.y = pk_fp8x4(bf2f((unsigned short)v[4]) * sc, bf2f((unsigned short)v[5]) * sc, bf2f((unsigned short)v[6]) * sc, bf2f((unsigned short)v[7]) * sc); return r; }
__device__ __forceinline__ f32x4 mfma8(u32x2 a, u32x2 b, f32x4 c) { return __builtin_amdgcn_mfma_f32_16x16x32_fp8_fp8(__builtin_bit_cast(long, a), __builtin_bit_cast(long, b), c, 0, 0, 0); }
__device__ __forceinline__ f32x4 mfma16(bf16x8 a, bf16x8 b, f32x4 c) { return __builtin_amdgcn_mfma_f32_16x16x32_bf16(a, b, c, 0, 0, 0); }
__device__ __forceinline__ bf16x8 cat44(bf16x4 lo, bf16x4 hi) { bf16x8 r; r[0] = lo[0]; r[1] = lo[1]; r[2] = lo[2]; r[3] = lo[3]; r[4] = hi[0]; r[5] = hi[1]; r[6] = hi[2]; r[7] = hi[3]; return r; }
__device__ __forceinline__ bf16x8 pack8(f32x4 a, f32x4 b) { u32x4 r; r.x = pk2(a.x, a.y); r.y = pk2(a.z, a.w); r.z = pk2(b.x, b.y); r.w = pk2(b.z, b.w); return __builtin_bit_cast(bf16x8, r); }

namespace pg8 {
constexpr int BM = 256, BK = 64, HALF = 128, HTB = HALF * BK * 2, STAGE_BYTES = 8 * HTB, NXCD = 8, WGM = 8;
__host__ __device__ __forceinline__ int lds_byte(int r, int c) { const int st = (r >> 4) * 2 + (c >> 5), rr = r & 15, cc = c & 31, ob = rr * 64 + cc * 2; return st * 1024 + (ob ^ (((ob >> 9) & 1) << 5)); }
__host__ __device__ __forceinline__ void stage_rc(int b, int& R, int& C) { const int st = b / 1024, sb = b % 1024, swz = sb ^ (((sb >> 9) & 1) << 5); R = (st >> 1) * 16 + swz / 64; C = (st & 1) * 32 + (swz % 64) / 2; }
struct Unit { int pm, pn; };
struct Gemm { const bf16_t* A; const bf16_t* Bt; int K, lda, ldb, kstepA, adiv, bdiv; size_t astride, bstride; };
struct StaticOrder {
    int nM, nN, nwg, G, c;
    __device__ void init(int M, int N, int G_, int c_) { nM = M / BM; nN = N / BM; nwg = nM * nN; G = G_; c = c_; }
    __device__ bool next(int i, Unit& u) const {
        const long L = (long)i * G + c; if (L >= nwg) return false;
        int wgid = (int)L; { const int q = nwg / NXCD, r = nwg % NXCD, xcd = wgid % NXCD, off = wgid / NXCD; wgid = (xcd < r ? xcd * (q + 1) : r * (q + 1) + (xcd - r) * q) + off; }
        const int nig = WGM * nN, gid = wgid / nig, fm = gid * WGM, gsz = (nM - fm) < WGM ? (nM - fm) : WGM;
        u.pm = fm + ((wgid % nig) % gsz); u.pn = (wgid % nig) / gsz; return true;
    }
};
template <class Epi>
__device__ __forceinline__ void gemm_phase(LAS unsigned char* lds, const Gemm g, const StaticOrder& S, const Epi& E) {
    int tid = threadIdx.x; asm volatile("" : "+v"(tid));
    const int wid = __builtin_amdgcn_readfirstlane(tid >> 6), lane = tid & 63, wr = wid >> 2, wc = wid & 3, fr = lane & 15, fq = lane >> 4;
    const int K = g.K, nt = K / BK;
    unsigned voffA[2], voffB[2];
#pragma unroll
    for (int i = 0; i < 2; ++i) { int R, C; stage_rc(tid * 16 + i * 8192, R, C); voffA[i] = (unsigned)(R * g.lda + C) * 2u; voffB[i] = (unsigned)(R * g.ldb + C) * 2u; }
    const size_t kstep = (size_t)(BK * 2), kstepA = (size_t)g.kstepA;
    const size_t hstepA = (size_t)HALF * g.lda * 2, hstepB = (size_t)HALF * g.ldb * 2;
    const size_t tstepA = 2 * hstepA, tstepB = 2 * hstepB;
    const unsigned ldsw = (unsigned)wid * 1024u;
    const int aoff = lds_byte(wr * 64 + fr, fq * 8), boff = lds_byte(wc * 32 + fr, fq * 8);
#define PG8_SA(b, h) (((b) * 2 + (h)) * HTB)
#define PG8_SB(b, h) ((4 + (b) * 2 + (h)) * HTB)
#define PG8_STAGE(bufoff, gbase, voff) do { _Pragma("unroll") for (int _i = 0; _i < 2; ++_i) \
        __builtin_amdgcn_global_load_lds((const unsigned*)((const char*)(gbase) + (voff)[_i]), (LAS unsigned*)(lds + (bufoff) + ldsw + _i * 8192), 16, 0, 0); } while (0)
#define PG8_LDA(dst, b, h) do { _Pragma("unroll") for (int m = 0; m < 4; ++m) _Pragma("unroll") for (int k = 0; k < 2; ++k) dst[m][k] = *(const LAS bf16x8*)(lds + PG8_SA(b, h) + aoff + m * 2048 + k * 1024); } while (0)
#define PG8_LDB(dst, b, h) do { _Pragma("unroll") for (int n = 0; n < 2; ++n) _Pragma("unroll") for (int k = 0; k < 2; ++k) dst[n][k] = *(const LAS bf16x8*)(lds + PG8_SB(b, h) + boff + n * 2048 + k * 1024); } while (0)
#define PG8_MMA(ai, bj, At, Bt) do { __builtin_amdgcn_s_setprio(1); _Pragma("unroll") for (int m = 0; m < 4; ++m) _Pragma("unroll") for (int n = 0; n < 2; ++n) _Pragma("unroll") for (int k = 0; k < 2; ++k) \
        acc[ai][bj][m][n] = __builtin_amdgcn_mfma_f32_16x16x32_bf16(Bt[n][k], At[m][k], acc[ai][bj][m][n], 0, 0, 0); __builtin_amdgcn_s_setprio(0); } while (0)
#define PG8_WAIT_V(n) asm volatile("s_waitcnt vmcnt(" #n ")" ::: "memory")
#define PG8_WAIT_L(n) asm volatile("s_waitcnt lgkmcnt(" #n ")" ::: "memory")
#define PG8_BAR __builtin_amdgcn_s_barrier()
#define PG8_SCHED __builtin_amdgcn_sched_barrier(0)
    Unit cur, nxt; int ui = 0;
    if (!S.next(0, cur)) return;
    f32x4 acc[2][2][4][2];
#pragma unroll
    for (int a = 0; a < 2; ++a)
#pragma unroll
        for (int b = 0; b < 2; ++b)
#pragma unroll
            for (int m = 0; m < 4; ++m)
#pragma unroll
                for (int n = 0; n < 2; ++n) acc[a][b][m][n] = (f32x4){0.f, 0.f, 0.f, 0.f};
    bf16x8 At[4][2], B0[2][2], B1[2][2];
    const char* cA = (const char*)(g.A + (size_t)(cur.pm / g.adiv) * g.astride) + (size_t)(cur.pm % g.adiv) * tstepA; const char* cB = (const char*)(g.Bt + (size_t)(cur.pm / g.bdiv) * g.bstride) + (size_t)cur.pn * tstepB;
    PG8_STAGE(PG8_SB(0, 0), cB, voffB); PG8_STAGE(PG8_SB(0, 1), cB + hstepB, voffB); PG8_STAGE(PG8_SA(0, 0), cA, voffA); PG8_STAGE(PG8_SA(0, 1), cA + hstepA, voffA);
    if (wr == 1) PG8_BAR;
    PG8_WAIT_V(2); PG8_BAR;
    PG8_STAGE(PG8_SB(1, 0), cB + kstep, voffB); PG8_STAGE(PG8_SA(1, 0), cA + kstepA, voffA); PG8_STAGE(PG8_SB(1, 1), cB + hstepB + kstep, voffB);
    PG8_WAIT_V(6); PG8_BAR;
    for (;;) {
        const bool has_next = S.next(ui + 1, nxt);
        const char* nA = has_next ? (const char*)(g.A + (size_t)(nxt.pm / g.adiv) * g.astride) + (size_t)(nxt.pm % g.adiv) * tstepA : cA;
        const char* nB = has_next ? (const char*)(g.Bt + (size_t)(nxt.pm / g.bdiv) * g.bstride) + (size_t)nxt.pn * tstepB : cB;
        for (int t = 0; t < nt; t += 2) {
            const bool last = (t == nt - 2);
            const char* a1 = cA + (size_t)(t + 1) * kstepA;
            const char* a2 = last ? nA : cA + (size_t)(t + 2) * kstepA; const char* b2 = last ? nB : cB + (size_t)(t + 2) * kstep;
            const char* a3 = a2 + kstepA; const char* b3 = b2 + kstep;
            PG8_LDB(B0, 0, 0); PG8_LDB(B1, 0, 1); PG8_SCHED; PG8_LDA(At, 0, 0); PG8_STAGE(PG8_SA(1, 1), a1 + hstepA, voffA);
            PG8_WAIT_V(8); PG8_WAIT_L(0); PG8_BAR; PG8_MMA(0, 0, At, B0); PG8_MMA(0, 1, At, B1); PG8_BAR; PG8_SCHED;
            PG8_LDA(At, 0, 1); PG8_STAGE(PG8_SB(0, 0), b2, voffB); PG8_STAGE(PG8_SB(0, 1), b2 + hstepB, voffB); PG8_STAGE(PG8_SA(0, 0), a2, voffA);
            PG8_WAIT_V(8); PG8_WAIT_L(0); PG8_BAR; PG8_MMA(1, 0, At, B0); PG8_MMA(1, 1, At, B1); PG8_BAR; PG8_SCHED;
            PG8_LDB(B0, 1, 0); PG8_LDB(B1, 1, 1); PG8_SCHED; PG8_LDA(At, 1, 0); PG8_STAGE(PG8_SA(0, 1), a2 + hstepA, voffA);
            PG8_WAIT_V(8); PG8_WAIT_L(0); PG8_BAR; PG8_MMA(0, 0, At, B0); PG8_MMA(0, 1, At, B1); PG8_BAR; PG8_SCHED;
            PG8_LDA(At, 1, 1); PG8_STAGE(PG8_SB(1, 0), b3, voffB); PG8_STAGE(PG8_SB(1, 1), b3 + hstepB, voffB); PG8_STAGE(PG8_SA(1, 0), a3, voffA);
            PG8_WAIT_V(8); PG8_WAIT_L(0); PG8_BAR; PG8_MMA(1, 0, At, B0); PG8_MMA(1, 1, At, B1); PG8_BAR; PG8_SCHED;
        }
        if (wr == 0) PG8_BAR;
        E(acc, cur, wr, wc, fr, fq);
#if (REP_MASK & 512)
        asm volatile("" ::: "memory"); E(acc, cur, wr, wc, fr, fq);
#endif
        if (!has_next) break;
#pragma unroll
        for (int a = 0; a < 2; ++a)
#pragma unroll
            for (int b = 0; b < 2; ++b)
#pragma unroll
                for (int m = 0; m < 4; ++m)
#pragma unroll
                    for (int n = 0; n < 2; ++n) acc[a][b][m][n] = (f32x4){0.f, 0.f, 0.f, 0.f};
        cur = nxt; cA = nA; cB = nB; ++ui;
        if (wr == 1) PG8_BAR;
    }
    PG8_WAIT_V(0);
    PG8_BAR;
#undef PG8_SA
#undef PG8_SB
#undef PG8_STAGE
#undef PG8_LDA
#undef PG8_LDB
#undef PG8_MMA
#undef PG8_WAIT_V
#undef PG8_WAIT_L
#undef PG8_BAR
#undef PG8_SCHED
}
}
typedef f32x4 AccT[2][2][4][2];

struct EpiBf {
    int mode; bf16_t* O; const float* aux; float* gates; float* dtp;
    __device__ __forceinline__ void operator()(const AccT& acc, const pg8::Unit& u, int wr, int wc, int fr, int fq) const {
        const int row0 = u.pm * 256 + wr * 64 + fr;
        if (mode == 0) {
            const int col0 = u.pn * 128 + wc * 32 + 8 * fq;
#pragma unroll
            for (int ai = 0; ai < 2; ++ai)
#pragma unroll
                for (int m = 0; m < 4; ++m) { u32x4 w;
#pragma unroll
                    for (int n = 0; n < 2; ++n) { const f32x4 gg = acc[ai][0][m][n], vv = acc[ai][1][m][n]; f32x4 o;
#pragma unroll
                        for (int e = 0; e < 4; ++e) o[e] = silu_f(gg[e]) * vv[e];
                        const u32x2 pkd = pk4(o); if (n == 0) { w.x = pkd.x; w.y = pkd.y; } else { w.z = pkd.x; w.w = pkd.y; } }
                    *(u32x4*)(O + (size_t)(row0 + ai * 128 + m * 16) * FF + col0) = w; }
        } else if (mode == 2) {
            const int col0 = wc * 32 + 8 * fq; const float* bp = aux + (u.pm >= 16 ? 256 : 0);
#pragma unroll
            for (int bj = 0; bj < 2; ++bj) { const f32x4 bv0 = *(const f32x4*)(bp + col0 + bj * 128), bv1 = *(const f32x4*)(bp + col0 + bj * 128 + 4);
#pragma unroll
                for (int ai = 0; ai < 2; ++ai)
#pragma unroll
                    for (int m = 0; m < 4; ++m) { f32x4 o0, o1;
#pragma unroll
                        for (int e = 0; e < 4; ++e) { o0[e] = gelu_tanh(acc[ai][bj][m][0][e] + bv0[e]); o1[e] = gelu_tanh(acc[ai][bj][m][1][e] + bv1[e]); }
                        const u32x2 p0 = pk4(o0), p1 = pk4(o1); u32x4 w; w.x = p0.x; w.y = p0.y; w.z = p1.x; w.w = p1.y;
                        *(u32x4*)(O + (size_t)(row0 + ai * 128 + m * 16) * 256 + col0 + bj * 128) = w; } }
        } else if (mode == 3 || u.pn < 11) {
            const int pn = u.pn; const int col0 = pn * 256 + wc * 32 + 8 * fq; const bool isq = mode == 1 && pn < 2, isg = mode == 1 && (pn == 5 || pn == 6); const int pitch = mode == 3 ? D : PP;
#pragma unroll
            for (int ai = 0; ai < 2; ++ai)
#pragma unroll
                for (int m = 0; m < 4; ++m) { bf16_t* rowp = O + (size_t)(row0 + ai * 128 + m * 16) * pitch + col0;
#pragma unroll
                    for (int bj = 0; bj < 2; ++bj) { u32x4 w;
#pragma unroll
                        for (int n = 0; n < 2; ++n) { f32x4 v = acc[ai][bj][m][n];
                            if (isq) v = v * 0.125f;
                            if (isg) {
#pragma unroll
                                for (int e = 0; e < 4; ++e) v[e] = gelu_tanh(v[e]); }
                            const u32x2 pkd = pk4(v); if (n == 0) { w.x = pkd.x; w.y = pkd.y; } else { w.z = pkd.x; w.w = pkd.y; } }
                        *(u32x4*)(rowp + bj * 128) = w; } }
        } else {
            if (wc == 0) {
                const f32x4 db = *(const f32x4*)aux;
#pragma unroll
                for (int ai = 0; ai < 2; ++ai)
#pragma unroll
                    for (int m = 0; m < 4; ++m) { const size_t row = (size_t)(row0 + ai * 128 + m * 16);
#pragma unroll
                        for (int n = 0; n < 2; ++n) { const int lc = 8 * fq + 4 * n; const f32x4 v = acc[ai][0][m][n];
                            if (lc < 24) { f32x4 o;
#pragma unroll
                                for (int e = 0; e < 4; ++e) o[e] = sigmoid_f(v[e]);
                                *(f32x4*)(gates + row * 24 + lc) = o; }
                            else if (lc == 24) { f32x4 o;
#pragma unroll
                                for (int e = 0; e < 4; ++e) o[e] = softplus_f(v[e] + db[e]);
                                *(f32x4*)(dtp + row * 4) = o; } } }
            }
        }
    }
};

__device__ __forceinline__ void transpose_item(const float* colp, int ldsrc, int K, bf16_t* WT, int k0, int n0, LAS float* scr, int lane) {
    float tv[32];
#pragma unroll
    for (int i = 0; i < 32; ++i) { const int kk = 2 * i + (lane >> 5); tv[i] = colp ? colp[(size_t)(k0 + kk) * ldsrc] : 0.f; }
#pragma unroll
    for (int i = 0; i < 32; ++i) { const int kk = 2 * i + (lane >> 5); scr[kk * 33 + (lane & 31)] = tv[i]; }
    WAVE_SYNC();
    const int c = lane & 7;
#pragma unroll
    for (int j = 0; j < 4; ++j) { const int n = (lane >> 3) + 8 * j; const LAS float* s = scr + (8 * c) * 33 + n;
        u32x4 o; o.x = pk2(s[0 * 33], s[1 * 33]); o.y = pk2(s[2 * 33], s[3 * 33]); o.z = pk2(s[4 * 33], s[5 * 33]); o.w = pk2(s[6 * 33], s[7 * 33]);
        *(u32x4*)(WT + (size_t)(n0 + n) * K + k0 + 8 * c) = o; }
    WAVE_SYNC();
}
__device__ __forceinline__ void gemv_item(LAS float* vl, LAS float* red, const float* W, int ldw, int K, int n0, const float* bias, float* out0, float* out1, int tid) {
    const int lane = tid & 63, wv = tid >> 6, kq = K / 8;
    float a0 = 0.f, a1 = 0.f; const float* wp = W + (size_t)(wv * kq) * ldw + n0 + lane;
#pragma unroll 8
    for (int k = 0; k < kq; ++k) { const float w = wp[(size_t)k * ldw]; a0 += vl[wv * kq + k] * w; a1 += vl[K + wv * kq + k] * w; }
    red[(wv * 64 + lane) * 2] = a0; red[(wv * 64 + lane) * 2 + 1] = a1;
    __syncthreads();
    if (tid < 128) { const int n = tid & 63, bb = tid >> 6; float s = 0.f;
#pragma unroll
        for (int w = 0; w < 8; ++w) s += red[(w * 64 + n) * 2 + bb];
        s += bias[n0 + n]; if (bb == 0) out0[n0 + n] = s; else if (out1) out1[n0 + n] = s; }
    __syncthreads();
}

__device__ __forceinline__ void ln_row2(const float* xi0, const float* xi1, const bf16_t* y0, const bf16_t* y1, const float* gt0, const float* gt1, float wgt,
                                        float* x0, float* x1, const float* gam, const float* bet, bf16_t* h0, bf16_t* h1,
                                        const float* sh0, const float* sc0, const float* sh1, const float* sc1, int lane) {
    f32x4 v[2][4]; u32x2 yr[2][4]; float s[2] = {0.f, 0.f};
#pragma unroll
    for (int j = 0; j < 4; ++j) { v[0][j] = __builtin_nontemporal_load((const f32x4*)(xi0 + 256 * j + 4 * lane)); v[1][j] = __builtin_nontemporal_load((const f32x4*)(xi1 + 256 * j + 4 * lane));
        yr[0][j] = __builtin_nontemporal_load((const u32x2*)(y0 + 256 * j + 4 * lane)); yr[1][j] = __builtin_nontemporal_load((const u32x2*)(y1 + 256 * j + 4 * lane)); }
#pragma unroll
    for (int j = 0; j < 4; ++j) { const int col = 256 * j + 4 * lane;
#pragma unroll
        for (int r = 0; r < 2; ++r) { const f32x4 gv = *(const f32x4*)((r ? gt1 : gt0) + col); const u32x2 q = yr[r][j];
            f32x4 yy; yy.x = bf2f(q.x & 0xffff); yy.y = bf2f(q.x >> 16); yy.z = bf2f(q.y & 0xffff); yy.w = bf2f(q.y >> 16);
            v[r][j] = v[r][j] * ALPHA + (gv + 1.f) * wgt * yy; } }
#pragma unroll
    for (int r = 0; r < 2; ++r)
#pragma unroll
        for (int j = 0; j < 4; ++j) s[r] += (v[r][j].x + v[r][j].y) + (v[r][j].z + v[r][j].w);
    float mean[2], rstd[2];
#pragma unroll
    for (int r = 0; r < 2; ++r) { mean[r] = wave_fsum(s[r]) * (1.f / D); float s2 = 0.f;
#pragma unroll
        for (int j = 0; j < 4; ++j) { v[r][j] = v[r][j] - mean[r]; s2 += (v[r][j].x * v[r][j].x + v[r][j].y * v[r][j].y) + (v[r][j].z * v[r][j].z + v[r][j].w * v[r][j].w); }
        rstd[r] = rsqrtf(wave_fsum(s2) * (1.f / D) + LN_EPS); }
#pragma unroll
    for (int j = 0; j < 4; ++j) { const int col = 256 * j + 4 * lane; const f32x4 g = *(const f32x4*)(gam + col), be = *(const f32x4*)(bet + col);
#pragma unroll
        for (int r = 0; r < 2; ++r) { f32x4 y = v[r][j] * rstd[r] * g + be; __builtin_nontemporal_store(y, (f32x4*)((r ? x1 : x0) + col));
            if (h0) { const f32x4 sc = *(const f32x4*)((r ? sc1 : sc0) + col), sh = *(const f32x4*)((r ? sh1 : sh0) + col); *(u32x2*)((r ? h1 : h0) + col) = pk4(y * (1.f + sc) + sh); } } }
}
__device__ __forceinline__ void mod_row(const float* xrow, bf16_t* hrow, const float* shift, const float* scale, int lane) {
#pragma unroll
    for (int j = 0; j < 4; ++j) { const int col = 256 * j + 4 * lane; const f32x4 y = __builtin_nontemporal_load((const f32x4*)(xrow + col)), sc = *(const f32x4*)(scale + col), sh = *(const f32x4*)(shift + col);
        *(u32x2*)(hrow + col) = pk4(y * (1.f + sc) + sh); }
}

__device__ __forceinline__ bf16x8 gather8(const LAS bf16_t* p, int stride) { bf16x8 r;
#pragma unroll
    for (int e = 0; e < 8; ++e) r[e] = (short)p[e * stride];
    return r; }
__device__ __forceinline__ bf16x8 gather44(const LAS bf16_t* p, int stride) { bf16x8 r;
#pragma unroll
    for (int e = 0; e < 4; ++e) { r[e] = (short)p[e * stride]; r[4 + e] = (short)p[(16 + e) * stride]; }
    return r; }
__device__ __forceinline__ void conv_tok8(const bf16_t* colbase  , int tpos, const float (&w)[4][8], const float (&bi)[8], float* a) {
#pragma unroll
    for (int e = 0; e < 8; ++e) a[e] = bi[e];
#pragma unroll
    for (int j = 0; j < 4; ++j) { if (tpos - 3 + j >= 0) { const bf16x8 rv = *(const bf16x8*)(colbase + (ptrdiff_t)(j - 3) * PP);
#pragma unroll
            for (int e = 0; e < 8; ++e) a[e] += w[j][e] * bf2f((unsigned short)rv[e]); } }
#pragma unroll
    for (int e = 0; e < 8; ++e) a[e] = silu_f(a[e]);
}
__device__ __forceinline__ void load_convw(const float* convw, const float* convb, int cidx, float (&w)[4][8], float (&bi)[8]) {
#pragma unroll
    for (int e = 0; e < 8; ++e) { bi[e] = convb[cidx + e];
#pragma unroll
        for (int j = 0; j < 4; ++j) w[j][e] = convw[j * 768 + cidx + e]; }
}

__device__ __forceinline__ void vt_item(LAS unsigned char* lds_wave, unsigned char* ws, int item, int lane) {
    const int tt = item & 255, slab = (item >> 8) & 3, which = item >> 10; const int b = slab >> 1, g = slab & 1, r = lane & 15, quad = lane >> 4;
    const bf16_t* Pk = (const bf16_t*)(ws + WS_U) + ((size_t)b * T + (size_t)tt * 64) * PP + (which ? PC_KW : PC_KS) + 64 * g;
    const bf16_t* Pv = (const bf16_t*)(ws + WS_U) + ((size_t)b * T + (size_t)tt * 64) * PP + (which ? PC_VW : PC_VS) + 64 * g;
    LAS bf16_t* scr = (LAS bf16_t*)lds_wave;
#pragma unroll
    for (int rr = 0; rr < 8; ++rr) { const int t = 8 * rr + (lane >> 3), ck = lane & 7; const u32x4 v = *(const u32x4*)(Pv + (size_t)t * PP + 8 * ck);
        LAS unsigned* d = (LAS unsigned*)(scr + t * 66 + 8 * ck); d[0] = v.x; d[1] = v.y; d[2] = v.z; d[3] = v.w; }
    if (which) {
        bf16_t* KF = (bf16_t*)(ws + WS_KWF) + (size_t)slab * T * 64 + (size_t)tt * 4096;
        bf16_t* VF = (bf16_t*)(ws + WS_VWT) + (size_t)slab * T * 64 + (size_t)tt * 4096;
#pragma unroll
        for (int tl = 0; tl < 4; ++tl)
#pragma unroll
            for (int ks = 0; ks < 2; ++ks) { const u32x4 v = *(const u32x4*)(Pk + (size_t)(16 * tl + r) * PP + 32 * ks + 8 * quad); *(u32x4*)(KF + ((tl * 2 + ks) * 64 + lane) * 8) = v; }
        WAVE_SYNC();
#pragma unroll
        for (int gq = 0; gq < 2; ++gq)
#pragma unroll
            for (int dt = 0; dt < 4; ++dt) { const bf16x8 o = gather44(scr + (32 * gq + 4 * quad) * 66 + 16 * dt + r, 66); *(bf16x8*)(VF + ((gq * 4 + dt) * 64 + lane) * 8) = o; }
    } else {
        unsigned char* KF = ws + WS_KSF + (size_t)slab * T * 64 + (size_t)tt * 4096;
        unsigned char* VF = ws + WS_VST + (size_t)slab * T * 64 + (size_t)tt * 4096;
#pragma unroll
        for (int tl = 0; tl < 4; ++tl) { const bf16_t* kr = Pk + (size_t)(16 * tl + r) * PP + 8 * quad;
            const u32x2 a = bf8_to_fp8(*(const bf16x8*)kr, 1.f), c2 = bf8_to_fp8(*(const bf16x8*)(kr + 32), 1.f);
            u32x4 o; o.x = a.x; o.y = a.y; o.z = c2.x; o.w = c2.y; *(u32x4*)(KF + (tl * 64 + lane) * 16) = o; }
        WAVE_SYNC();
#pragma unroll
        for (int gq = 0; gq < 2; ++gq)
#pragma unroll
            for (int dp = 0; dp < 2; ++dp) { const u32x2 a = bf8_to_fp8(gather44(scr + (32 * gq + 4 * quad) * 66 + 16 * (2 * dp) + r, 66), 1.f), c2 = bf8_to_fp8(gather44(scr + (32 * gq + 4 * quad) * 66 + 16 * (2 * dp + 1) + r, 66), 1.f);
                u32x4 o; o.x = a.x; o.y = a.y; o.z = c2.x; o.w = c2.y; *(u32x4*)(VF + ((gq * 2 + dp) * 64 + lane) * 16) = o; }
    }
    WAVE_SYNC();
}

__device__ __forceinline__ void gmlp_item(LAS unsigned char* lds, unsigned char* ws, const float* lng, const float* lnb, const bf16_t* GW, const float* bs, int item, int tid) {
    const int lane = tid & 63, wv = tid >> 6, c = lane & 15, quad = lane >> 4;
    const int b = item >> 7, cc = item & 127; const size_t tok0 = (size_t)b * T + (size_t)cc * 128;
    const bf16_t* P = (const bf16_t*)(ws + WS_U); bf16_t* CAT = (bf16_t*)(ws + WS_H);
    LAS bf16_t* vN = (LAS bf16_t*)lds;
    constexpr int VS = 258;
    {   const f32x4 g4 = *(const f32x4*)(lng + 4 * lane), b4 = *(const f32x4*)(lnb + 4 * lane);
        for (int s0 = wv; s0 < 128; s0 += 16) {
            f32x4 v[2];
#pragma unroll
            for (int k = 0; k < 2; ++k) { const u32x2 raw = *(const u32x2*)(P + (tok0 + s0 + 8 * k) * PP + PC_V + 4 * lane);
                v[k].x = bf2f(raw.x & 0xffff); v[k].y = bf2f(raw.x >> 16); v[k].z = bf2f(raw.y & 0xffff); v[k].w = bf2f(raw.y >> 16); }
            float mean[2], rstd[2];
#pragma unroll
            for (int k = 0; k < 2; ++k) mean[k] = wave_fsum((v[k].x + v[k].y) + (v[k].z + v[k].w)) * (1.f / 256.f);
#pragma unroll
            for (int k = 0; k < 2; ++k) { v[k] = v[k] - mean[k]; rstd[k] = rsqrtf(wave_fsum((v[k].x * v[k].x + v[k].y * v[k].y) + (v[k].z * v[k].z + v[k].w * v[k].w)) * (1.f / 256.f) + LN_EPS); }
#pragma unroll
            for (int k = 0; k < 2; ++k) { const f32x4 o = v[k] * rstd[k] * g4 + b4;
                LAS unsigned* d = (LAS unsigned*)(vN + (s0 + 8 * k) * VS + 4 * lane); d[0] = pk2(o.x, o.y); d[1] = pk2(o.z, o.w); }
        }
    }
    __syncthreads();
    {   const int tt = wv, t = 16 * tt + c; const int nks = (16 * tt + 15) / 32 + 1;
        for (int grp = 0; grp < 4; ++grp) {
            f32x4 acc[4];
#pragma unroll
            for (int dt = 0; dt < 4; ++dt) acc[dt] = (f32x4){0.f, 0.f, 0.f, 0.f};
            const bf16_t* wrow = GW + ((size_t)grp * 128 + t) * 128 + 8 * quad;
            for (int ks = 0; ks < nks; ++ks) {
                const bf16x8 bw = *(const bf16x8*)(wrow + 32 * ks);
#pragma unroll
                for (int dt = 0; dt < 4; ++dt) { const bf16x8 av = gather8(vN + (32 * ks + 8 * quad) * VS + 64 * grp + 16 * dt + c, VS); acc[dt] = mfma16(av, bw, acc[dt]); }
            }
            const float bsv = bs[grp * 128 + t];
#pragma unroll
            for (int dt = 0; dt < 4; ++dt) { const int col = 64 * grp + 16 * dt + 4 * quad;
                const u32x2 raw = *(const u32x2*)(P + (tok0 + t) * PP + PC_U + col);
                f32x4 o; o.x = bf2f(raw.x & 0xffff) * (acc[dt].x + bsv); o.y = bf2f(raw.x >> 16) * (acc[dt].y + bsv); o.z = bf2f(raw.y & 0xffff) * (acc[dt].z + bsv); o.w = bf2f(raw.y >> 16) * (acc[dt].w + bsv);
                *(u32x2*)(CAT + (tok0 + t) * 1024 + 512 + col) = pk4(o); }
        }
    }
    __syncthreads();
}

__device__ __forceinline__ void ssd_s1_item(LAS unsigned char* lds, unsigned char* ws, const float* convw, const float* convb, const float* alog, int item, int tid) {
    const int lane = tid & 63, wv = tid >> 6, c = lane & 15, quad = lane >> 4;
    const int g = item & 1, ch = (item >> 1) & 63, b = item >> 7; const size_t tok0 = (size_t)b * T + (size_t)ch * 256;
    constexpr int RS = 258;
    LAS bf16_t* sm = (LAS bf16_t*)lds;
    LAS float* csl = (LAS float*)(lds + 256 * RS * 2);
    LAS float* dtl = csl + 512;
    const float* DT = (const float*)(ws + WS_DT); float* CS = (float*)(ws + WS_CS); float* CSL = (float*)(ws + WS_CSL);
    if (wv < 2) {
        const int h = 2 * g + wv; const float A = -__expf(alog[h]);
        float dv[4], cv[4]; float run = 0.f;
#pragma unroll
        for (int e = 0; e < 4; ++e) { dv[e] = DT[(tok0 + 4 * lane + e) * 4 + h]; run += A * dv[e]; cv[e] = run; }
        float incl = run;
#pragma unroll
        for (int o = 1; o < 64; o <<= 1) { const float y = __shfl_up(incl, o); if (lane >= o) incl += y; }
        const float excl = incl - run;
#pragma unroll
        for (int e = 0; e < 4; ++e) { const float cs = cv[e] + excl; csl[wv * 256 + 4 * lane + e] = cs; dtl[wv * 256 + 4 * lane + e] = dv[e]; CS[(tok0 + 4 * lane + e) * 4 + h] = cs; }
        if (lane == 63) CSL[((size_t)b * 64 + ch) * 4 + h] = incl;
    }
    __syncthreads();
    {   const bf16_t* P = (const bf16_t*)(ws + WS_U); const int oct = tid & 31; const bool isx = oct < 16;
        const int cidx = isx ? 128 * g + 8 * oct : 256 + 128 * g + 8 * (oct - 16); const int pcol = isx ? PC_X + 128 * g + 8 * oct : PC_B + 128 * g + 8 * (oct - 16);
        float w[4][8], bi[8]; load_convw(convw, convb, cidx, w, bi);
        const int hh = (oct >> 3) & 1; const float cl = csl[hh * 256 + 255];
        for (int l = tid >> 5; l < 256; l += 16) {
            float a[8]; conv_tok8(P + (tok0 + l) * PP + pcol, ch * 256 + l, w, bi, a);
            if (isx) { const float sc = dtl[hh * 256 + l] * __expf(cl - csl[hh * 256 + l]);
#pragma unroll
                for (int e = 0; e < 8; ++e) a[e] *= sc; }
            LAS unsigned* d = (LAS unsigned*)(sm + l * RS + 8 * oct); d[0] = pk2(a[0], a[1]); d[1] = pk2(a[2], a[3]); d[2] = pk2(a[4], a[5]); d[3] = pk2(a[6], a[7]);
        }
    }
    __syncthreads();
    {   const int hh = wv >> 2, nq = wv & 3;
        f32x4 acc[4][2];
#pragma unroll
        for (int mt = 0; mt < 4; ++mt) { acc[mt][0] = (f32x4){0.f, 0.f, 0.f, 0.f}; acc[mt][1] = (f32x4){0.f, 0.f, 0.f, 0.f}; }
        for (int ks = 0; ks < 8; ++ks) {
            const LAS bf16_t* rowb = sm + (32 * ks + 8 * quad) * RS;
            bf16x8 bfr[2];
#pragma unroll
            for (int nt = 0; nt < 2; ++nt) bfr[nt] = gather8(rowb + 128 + 32 * nq + 16 * nt + c, RS);
#pragma unroll
            for (int mt = 0; mt < 4; ++mt) { const bf16x8 af = gather8(rowb + hh * 64 + 16 * mt + c, RS);
                acc[mt][0] = mfma16(af, bfr[0], acc[mt][0]); acc[mt][1] = mfma16(af, bfr[1], acc[mt][1]); }
        }
        float* ST = (float*)(ws + WS_STATES) + (((size_t)b * 64 + ch) * 4 + 2 * g + hh) * 8192;
#pragma unroll
        for (int mt = 0; mt < 4; ++mt)
#pragma unroll
            for (int nt = 0; nt < 2; ++nt)
#pragma unroll
                for (int j = 0; j < 4; ++j) ST[(16 * mt + 4 * quad + j) * 128 + 32 * nq + 16 * nt + c] = acc[mt][nt][j];
    }
    __syncthreads();
}

__device__ __forceinline__ void ssd_s3_item(LAS unsigned char* lds, unsigned char* ws, const float* convw, const float* convb, const float* dskip, const float* normg, int item, int tid) {
    const int lane = tid & 63, wv = tid >> 6, c = lane & 15, quad = lane >> 4;
    const int g = item & 1, ch = (item >> 1) & 63, b = item >> 7; const size_t tok0 = (size_t)b * T + (size_t)ch * 256;
    constexpr int BS = 136, XS = 132;
    LAS bf16_t* Bc = (LAS bf16_t*)lds;
    LAS bf16_t* Xd = (LAS bf16_t*)(lds + 256 * BS * 2);
    LAS float* csl = (LAS float*)(lds + 256 * BS * 2 + 256 * XS * 2);
    LAS float* dtl = csl + 512;
    const float* DT = (const float*)(ws + WS_DT); const float* CS = (const float*)(ws + WS_CS);
    const bf16_t* P = (const bf16_t*)(ws + WS_U);
    {   const int hh = tid >> 8, l = tid & 255; csl[hh * 256 + l] = CS[(tok0 + l) * 4 + 2 * g + hh]; dtl[hh * 256 + l] = DT[(tok0 + l) * 4 + 2 * g + hh]; }
    LAS float* cwl = dtl + 512;
    for (int i = tid; i < 640; i += NTHREADS) { const int j = i >> 7, chn = i & 127; cwl[i] = j < 4 ? convw[j * 768 + 512 + 128 * g + chn] : convb[512 + 128 * g + chn]; }
    __syncthreads();
    {   const int oct = tid & 15;
        {   float w[4][8], bi[8]; load_convw(convw, convb, 256 + 128 * g + 8 * oct, w, bi);
            for (int s = tid >> 4; s < 256; s += 32) { float a[8]; conv_tok8(P + (tok0 + s) * PP + PC_B + 128 * g + 8 * oct, ch * 256 + s, w, bi, a);
                u32x4 pk; pk.x = pk2(a[0], a[1]); pk.y = pk2(a[2], a[3]); pk.z = pk2(a[4], a[5]); pk.w = pk2(a[6], a[7]);
                *(LAS u32x4*)(Bc + s * BS + 8 * oct) = pk; } }
        {   float w[4][8], bi[8]; load_convw(convw, convb, 128 * g + 8 * oct, w, bi); const int hh = oct >> 3;
            for (int s = tid >> 4; s < 256; s += 32) { float a[8]; conv_tok8(P + (tok0 + s) * PP + PC_X + 128 * g + 8 * oct, ch * 256 + s, w, bi, a);
                const float sc = dtl[hh * 256 + s];
                LAS u32x2* d = (LAS u32x2*)(Xd + s * XS + 8 * oct); u32x2 p0, p1; p0.x = pk2(a[0] * sc, a[1] * sc); p0.y = pk2(a[2] * sc, a[3] * sc); p1.x = pk2(a[4] * sc, a[5] * sc); p1.y = pk2(a[6] * sc, a[7] * sc);
                d[0] = p0; d[1] = p1; } }
    }
    __syncthreads();
    const bf16_t* PREV = (const bf16_t*)(ws + WS_PREV) + (((size_t)b * 64 + ch) * 4 + 2 * g) * 8192;
    bf16_t* CAT = (bf16_t*)(ws + WS_H);
    for (int lt = wv; lt < 16; lt += 8) {
        const int l0 = 16 * lt, l = l0 + c;
        bf16x8 cf[4];
#pragma unroll
        for (int ks = 0; ks < 4; ++ks) {
            float w[4][8], bi[8];
#pragma unroll
            for (int j = 0; j < 4; ++j) { const f32x4 a0 = *(const LAS f32x4*)(cwl + j * 128 + 32 * ks + 8 * quad), a1 = *(const LAS f32x4*)(cwl + j * 128 + 32 * ks + 8 * quad + 4);
                w[j][0] = a0.x; w[j][1] = a0.y; w[j][2] = a0.z; w[j][3] = a0.w; w[j][4] = a1.x; w[j][5] = a1.y; w[j][6] = a1.z; w[j][7] = a1.w; }
            { const f32x4 a0 = *(const LAS f32x4*)(cwl + 512 + 32 * ks + 8 * quad), a1 = *(const LAS f32x4*)(cwl + 512 + 32 * ks + 8 * quad + 4);
                bi[0] = a0.x; bi[1] = a0.y; bi[2] = a0.z; bi[3] = a0.w; bi[4] = a1.x; bi[5] = a1.y; bi[6] = a1.z; bi[7] = a1.w; }
            float a[8]; conv_tok8(P + (tok0 + l) * PP + PC_C + 128 * g + 32 * ks + 8 * quad, ch * 256 + l, w, bi, a);
            u32x4 pk; pk.x = pk2(a[0], a[1]); pk.y = pk2(a[2], a[3]); pk.z = pk2(a[4], a[5]); pk.w = pk2(a[6], a[7]);
            cf[ks] = __builtin_bit_cast(bf16x8, pk);
        }
        const float csl0 = csl[l], csl1 = csl[256 + l];
        f32x4 Y[2][4];
#pragma unroll
        for (int hh = 0; hh < 2; ++hh) { const float sc = __expf(hh ? csl1 : csl0);
#pragma unroll
            for (int pt = 0; pt < 4; ++pt) { f32x4 a = (f32x4){0.f, 0.f, 0.f, 0.f};
#pragma unroll
                for (int ks = 0; ks < 4; ++ks) { const bf16x8 pf = *(const bf16x8*)(PREV + (size_t)hh * 8192 + (16 * pt + c) * 128 + 32 * ks + 8 * quad); a = mfma16(pf, cf[ks], a); }
                Y[hh][pt] = a * sc; } }
        const int nsg = (l0 + 15) / 32 + 1;
        for (int sg = 0; sg < nsg; ++sg) {
            const int s0 = 32 * sg;
            f32x4 S0 = (f32x4){0.f, 0.f, 0.f, 0.f}, S1 = (f32x4){0.f, 0.f, 0.f, 0.f};
#pragma unroll
            for (int ks = 0; ks < 4; ++ks) { const bf16x8 b0 = *(const LAS bf16x8*)(Bc + (s0 + c) * BS + 32 * ks + 8 * quad), b1 = *(const LAS bf16x8*)(Bc + (s0 + 16 + c) * BS + 32 * ks + 8 * quad);
                S0 = mfma16(b0, cf[ks], S0); S1 = mfma16(b1, cf[ks], S1); }
#pragma unroll
            for (int hh = 0; hh < 2; ++hh) { const float cl = hh ? csl1 : csl0;
                f32x4 P0, P1;
#pragma unroll
                for (int j = 0; j < 4; ++j) { const int sa = s0 + 4 * quad + j, sb = sa + 16;
                    P0[j] = sa <= l ? S0[j] * __expf(cl - csl[hh * 256 + sa]) : 0.f; P1[j] = sb <= l ? S1[j] * __expf(cl - csl[hh * 256 + sb]) : 0.f; }
                const bf16x8 pf = pack8(P0, P1);
#pragma unroll
                for (int pt = 0; pt < 4; ++pt) { const bf16x8 xa = gather44(Xd + (s0 + 4 * quad) * XS + hh * 64 + 16 * pt + c, XS); Y[hh][pt] = mfma16(xa, pf, Y[hh][pt]); } }
        }
        float ss = 0.f;
#pragma unroll
        for (int hh = 0; hh < 2; ++hh) { const float dsk = dskip[2 * g + hh], idt = 1.f / dtl[hh * 256 + l];
#pragma unroll
            for (int pt = 0; pt < 4; ++pt) { const int chn = 128 * g + 64 * hh + 16 * pt + 4 * quad;
                const u32x2 zr = *(const u32x2*)(P + (tok0 + l) * PP + PC_Z + chn);
                const u32x2 xr = *(const LAS u32x2*)(Xd + l * XS + hh * 64 + 16 * pt + 4 * quad);
                const float zz[4] = {bf2f(zr.x & 0xffff), bf2f(zr.x >> 16), bf2f(zr.y & 0xffff), bf2f(zr.y >> 16)};
                const float xx[4] = {bf2f(xr.x & 0xffff), bf2f(xr.x >> 16), bf2f(xr.y & 0xffff), bf2f(xr.y >> 16)};
#pragma unroll
                for (int j = 0; j < 4; ++j) { const float y = (Y[hh][pt][j] + dsk * xx[j] * idt) * silu_f(zz[j]); Y[hh][pt][j] = y; ss += y * y; } } }
        ss = qsum(ss); const float rms = rsqrtf(ss * (1.f / 128.f) + LN_EPS);
#pragma unroll
        for (int hh = 0; hh < 2; ++hh)
#pragma unroll
            for (int pt = 0; pt < 4; ++pt) { const int chn = 128 * g + 64 * hh + 16 * pt + 4 * quad; const f32x4 ng = *(const f32x4*)(normg + chn);
                *(u32x2*)(CAT + (tok0 + l) * 1024 + 768 + chn) = pk4(Y[hh][pt] * rms * ng); }
    }
    __syncthreads();
}

__device__ __forceinline__ void attn_item(LAS unsigned char* lds, unsigned char* ws, int b, int g, int qt, int tid) {
    const int lane = tid & 63, wv = __builtin_amdgcn_readfirstlane(tid >> 6);
    const int slab = b * 2 + g, t0 = qt * 128 + 16 * wv;
    LAS float* imp = (LAS float*)(lds + wv * 17664);
    LAS int* sell = (LAS int*)(lds + wv * 17664 + 16384);
    LAS int* selc = sell + 256;
    const LAS float* lut = (const LAS float*)(lds + LDS_LUT) + (4 * g) * 128;
    const bf16_t* Qb = (const bf16_t*)(ws + WS_U); const float* GT = (const float*)(ws + WS_GATES);
    bf16_t* CAT = (bf16_t*)(ws + WS_H);
#define LANE_VIEW() int ln_ = lane; asm volatile("" : "+v"(ln_)); const int c = ln_ & 15, quad = ln_ >> 4, tq = t0 + c; const size_t tokq = (size_t)b * T + tq; (void)tq; (void)tokq; (void)quad
    for (int i = lane; i < 16 * 256; i += 64) imp[i] = 0.f;
    WAVE_SYNC();
#define LOAD_QF() float biasfar[4]; _Pragma("unroll") for (int i = 0; i < 4; ++i) biasfar[i] = lut[i * 128 + 127]; bf16x8 qf[4][2]; _Pragma("unroll") for (int i = 0; i < 4; ++i) _Pragma("unroll") for (int ks = 0; ks < 2; ++ks) qf[i][ks] = *(const bf16x8*)(Qb + tokq * PP + (4 * g + i) * 64 + 32 * ks + 8 * quad)
    f32x4 O[4][4];
#if EN_CMP
    {
        LANE_VIEW(); LOAD_QF();
        const bf16_t* KC = (const bf16_t*)(ws + WS_KCMP) + (size_t)slab * 1024 * 64 + ln_ * 8; const bf16_t* VCT = (const bf16_t*)(ws + WS_VCMPT) + (size_t)slab * 64 * 1024 + ln_ * 8;
        const int ngrp = t0 >= 16 ? ((t0 / 16 - 1) / 32 + 1) : 0;
        float m[4], l[4];
#pragma unroll
        for (int i = 0; i < 4; ++i) { m[i] = -1e30f; l[i] = 0.f; }
#define CMP_LOADK(kf, grp_) do { const bf16_t* kp_ = KC + (size_t)(grp_) * 2048; _Pragma("unroll") for (int tl = 0; tl < 2; ++tl) _Pragma("unroll") for (int ks = 0; ks < 2; ++ks) kf[tl][ks] = *(const bf16x8*)(kp_ + (tl * 2 + ks) * 512); } while (0)
#define CMP_LOADV(vf, grp_) do { const bf16_t* vp_ = VCT + (size_t)(grp_) * 2048; _Pragma("unroll") for (int dt = 0; dt < 4; ++dt) vf[dt] = *(const bf16x8*)(vp_ + dt * 512); } while (0)
#define CMP_SCORES(kf, k0, i) f32x4 s[2]; _Pragma("unroll") for (int tl = 0; tl < 2; ++tl) { s[tl] = mfma16(kf[tl][0], qf[i][0], (f32x4){0.f, 0.f, 0.f, 0.f}); s[tl] = mfma16(kf[tl][1], qf[i][1], s[tl]); } \
            if (far) {   \
                _Pragma("unroll") for (int tl = 0; tl < 2; ++tl) _Pragma("unroll") for (int j = 0; j < 4; ++j) s[tl][j] = (s[tl][j] + biasfar[i]) * LOG2E; } \
            else { _Pragma("unroll") for (int tl = 0; tl < 2; ++tl) _Pragma("unroll") for (int j = 0; j < 4; ++j) { const int dist = tq - (16 * ((k0) + 16 * tl + 4 * quad + j) + 31); \
                const float bias = lut[i * 128 + min(max(dist, 0), 127)]; s[tl][j] = dist >= 0 ? (s[tl][j] + bias) * LOG2E : -INFINITY; } }
#define P1_COMPUTE(kf, grp_) do { const int k0 = 32 * (grp_); const bool far = (t0 - (16 * (k0 + 31) + 31)) >= 127; \
            _Pragma("unroll") for (int i = 0; i < 4; ++i) { CMP_SCORES(kf, k0, i) \
                float mx = fmaxf(fmaxf(fmaxf(s[0][0], s[0][1]), fmaxf(s[0][2], s[0][3])), fmaxf(fmaxf(s[1][0], s[1][1]), fmaxf(s[1][2], s[1][3]))); \
                mx = qmax(mx); const float mn = fmaxf(m[i], mx); float ps = 0.f; \
                _Pragma("unroll") for (int tl = 0; tl < 2; ++tl) _Pragma("unroll") for (int j = 0; j < 4; ++j) ps += __builtin_amdgcn_exp2f(s[tl][j] - mn); \
                ps = qsum(ps); l[i] = l[i] * __builtin_amdgcn_exp2f(m[i] - mn) + ps; m[i] = mn; } } while (0)
        {
            bf16x8 kA[2][2], kB[2][2];
            if (ngrp > 0) CMP_LOADK(kA, 0);
            for (int grp = 0; grp < ngrp; grp += 2) {
                CMP_LOADK(kB, min(grp + 1, ngrp - 1));
                P1_COMPUTE(kA, grp);
                if (grp + 1 >= ngrp) break;
                CMP_LOADK(kA, min(grp + 2, ngrp - 1));
                P1_COMPUTE(kB, grp + 1);
            }
        }
        float il[4];
#pragma unroll
        for (int i = 0; i < 4; ++i) il[i] = 1.f / fmaxf(l[i], 1e-30f);
#pragma unroll
        for (int i = 0; i < 4; ++i)
#pragma unroll
            for (int dt = 0; dt < 4; ++dt) O[i][dt] = (f32x4){0.f, 0.f, 0.f, 0.f};
#define P2_COMPUTE(kf, vf, grp_) do { const int k0 = 32 * (grp_); const bool far = (t0 - (16 * (k0 + 31) + 31)) >= 127; \
            float mainv[2] = {0.f, 0.f}, spill[2] = {0.f, 0.f}; \
            _Pragma("unroll") for (int i = 0; i < 4; ++i) { CMP_SCORES(kf, k0, i) \
                _Pragma("unroll") for (int tl = 0; tl < 2; ++tl) { _Pragma("unroll") for (int j = 0; j < 4; ++j) s[tl][j] = __builtin_amdgcn_exp2f(s[tl][j] - m[i]) * il[i]; \
                    mainv[tl] += (s[tl][0] + s[tl][1]) + (s[tl][2] + 0.5f * s[tl][3]); spill[tl] += 0.5f * s[tl][3]; } \
                const bf16x8 pf = pack8(s[0], s[1]); \
                _Pragma("unroll") for (int dt = 0; dt < 4; ++dt) O[i][dt] = mfma16(vf[dt], pf, O[i][dt]); } \
            const int nb = k0 / 4 + quad; \
            imp[c * 256 + nb] += mainv[0]; imp[c * 256 + nb + 4] += mainv[1]; asm volatile("" ::: "memory"); __builtin_amdgcn_wave_barrier(); \
            imp[c * 256 + nb + 1] += spill[0]; asm volatile("" ::: "memory"); __builtin_amdgcn_wave_barrier(); \
            if (nb + 5 < 256) imp[c * 256 + nb + 5] += spill[1]; \
            asm volatile("" ::: "memory"); __builtin_amdgcn_wave_barrier(); } while (0)
        {
            bf16x8 kA[2][2], vA[4];
            for (int grp = 0; grp < ngrp; ++grp) {
                CMP_LOADK(kA, grp); CMP_LOADV(vA, grp);
                P2_COMPUTE(kA, vA, grp);
            }
        }
#undef CMP_LOADK
#undef CMP_LOADV
#undef CMP_SCORES
#undef P1_COMPUTE
#undef P2_COMPUTE
    }
#else
#pragma unroll
    for (int i = 0; i < 4; ++i)
#pragma unroll
        for (int dt = 0; dt < 4; ++dt) O[i][dt] = (f32x4){0.f, 0.f, 0.f, 0.f};
#endif
    WAVE_SYNC();
    {
        const int cur = t0 >> 6; const int nf = 1 + (cur >= 1 ? 1 : 0) + (cur >= 2 ? 1 : 0), nr = min(16 - nf, max(cur - 2, 0));
        if (lane < 16) { sell[lane * 16] = 0; if (cur >= 1) sell[lane * 16 + 1] = cur; if (cur >= 2) sell[lane * 16 + 2] = cur - 1; selc[lane] = nf + nr; }
        for (int qi = 0; qi < 16; qi += 2) {
            unsigned v0[4], v1[4];
#pragma unroll
            for (int r = 0; r < 4; ++r) { const int n = lane + 64 * r; const bool okn = (n >= 1 && n <= cur - 2);
                const unsigned x0 = (__builtin_bit_cast(unsigned, imp[qi * 256 + n]) & 0xFFFFFF00u) | (unsigned)(255 - n);
                const unsigned x1 = (__builtin_bit_cast(unsigned, imp[(qi + 1) * 256 + n]) & 0xFFFFFF00u) | (unsigned)(255 - n);
                v0[r] = okn ? x0 : 0u; v1[r] = okn ? x1 : 0u; }
            for (int round = 0; round < nr; ++round) {
                const unsigned b0 = wave_umax(max(max(v0[0], v0[1]), max(v0[2], v0[3])));
                const unsigned b1 = wave_umax(max(max(v1[0], v1[1]), max(v1[2], v1[3])));
                const int i0 = 255 - (int)(b0 & 0xFFu), i1 = 255 - (int)(b1 & 0xFFu);
                if (lane == 0) { sell[qi * 16 + nf + round] = i0; sell[(qi + 1) * 16 + nf + round] = i1; }
#pragma unroll
                for (int r = 0; r < 4; ++r) { if (i0 == lane + 64 * r) v0[r] = 0u; if (i1 == lane + 64 * r) v1[r] = 0u; }
            }
        }
    }
    WAVE_SYNC();
    {
        LANE_VIEW();
#pragma unroll
        for (int i = 0; i < 4; ++i) { const float g0 = GT[tokq * 24 + (4 * g + i) * 3 + 0];
#pragma unroll
            for (int dt = 0; dt < 4; ++dt) *(LAS f32x4*)(imp + c * 256 + i * 64 + 16 * dt + 4 * quad) = O[i][dt] * g0; }
    }
    WAVE_SYNC();
#if EN_SEL
    {
        LANE_VIEW();
        const unsigned char* KSu = ws + WS_KSF + (size_t)slab * T * 64;
        const unsigned char* VSTu = ws + WS_VST + (size_t)slab * T * 64;
        const unsigned koff = (unsigned)ln_ * 16u;
        const int hc = c & 3; const float bfar = lut[hc * 128 + 127];
        const bool tsel1 = (c & 4) != 0, tsel2 = (c & 8) != 0; const int ktl = 16 * (c >> 2) + 4 * quad;
        const bool r4t1 = __builtin_amdgcn_readfirstlane(DPP_ROR(ln_ & 15, 4)) == 4;
        for (int qi = 0; qi < 16; ++qi) {
            const int tqq = t0 + qi, cur = tqq >> 6; const size_t tk = (size_t)b * T + tqq;
            u32x2 qs[2];
#pragma unroll
            for (int ks = 0; ks < 2; ++ks) qs[ks] = bf8_to_fp8(*(const bf16x8*)(Qb + tk * PP + (4 * g + hc) * 64 + 32 * ks + 8 * quad), 8.f);
            const int cnt = __builtin_amdgcn_readfirstlane(selc[qi]);
            float m = -1e30f, l = 0.f; f32x4 Os[4];
#pragma unroll
            for (int dt = 0; dt < 4; ++dt) Os[dt] = (f32x4){0.f, 0.f, 0.f, 0.f};
            u32x4 kA[4], kB[4], vA[4];
#define SEL_LOADK(kf, n) do { const unsigned char* kp_ = KSu + (size_t)(n) * 4096 + koff; _Pragma("unroll") for (int tl = 0; tl < 4; ++tl) kf[tl] = *(const u32x4*)(kp_ + tl * 1024); } while (0)
#define SEL_LOADV(vf, n) do { const unsigned char* vp_ = VSTu + (size_t)(n) * 4096 + koff; _Pragma("unroll") for (int q4 = 0; q4 < 4; ++q4) vf[q4] = *(const u32x4*)(vp_ + q4 * 1024); } while (0)
#define SEL_COMPUTE(kf, vf, n) do { f32x4 s[4]; \
            _Pragma("unroll") for (int tl = 0; tl < 4; ++tl) { s[tl] = mfma8((u32x2){kf[tl].x, kf[tl].y}, qs[0], (f32x4){0.f, 0.f, 0.f, 0.f}); s[tl] = mfma8((u32x2){kf[tl].z, kf[tl].w}, qs[1], s[tl]); } \
              \
            f32x4 u; _Pragma("unroll") for (int j = 0; j < 4; ++j) { const float a_ = tsel1 ? s[1][j] : s[0][j], b_ = tsel1 ? s[3][j] : s[2][j]; u[j] = (tsel2 ? b_ : a_) * 0.125f; } \
            const int kb_ = 64 * (n) + ktl; \
            if ((n) >= cur - 2) { _Pragma("unroll") for (int j = 0; j < 4; ++j) { const int dist = tqq - (kb_ + j); \
                    const float bias = lut[hc * 128 + min(max(dist, 0), 127)]; u[j] = dist >= 0 ? (u[j] + bias) * LOG2E : -INFINITY; } } \
            else { _Pragma("unroll") for (int j = 0; j < 4; ++j) u[j] = (u[j] + bfar) * LOG2E; } \
            float mx = fmaxf(fmaxf(u[0], u[1]), fmaxf(u[2], u[3])); \
            mx = fmaxf(mx, __builtin_bit_cast(float, DPP_ROR(__builtin_bit_cast(int, mx), 4))); mx = fmaxf(mx, __builtin_bit_cast(float, DPP_ROR(__builtin_bit_cast(int, mx), 8))); mx = qmax(mx); \
            if (__builtin_amdgcn_ballot_w64(mx > m) != 0ull) { const float mn = fmaxf(m, mx), al = __builtin_amdgcn_exp2f(m - mn); l *= al; m = mn; \
                _Pragma("unroll") for (int dt = 0; dt < 4; ++dt) Os[dt] = Os[dt] * al; } \
            _Pragma("unroll") for (int j = 0; j < 4; ++j) u[j] = __builtin_amdgcn_exp2f(u[j] - m); \
            float ps = (u[0] + u[1]) + (u[2] + u[3]); \
            ps += __builtin_bit_cast(float, DPP_ROR(__builtin_bit_cast(int, ps), 4)); ps += __builtin_bit_cast(float, DPP_ROR(__builtin_bit_cast(int, ps), 8)); ps = qsum(ps); l += ps; \
            const unsigned p4 = pk_fp8x4(u[0], u[1], u[2], u[3]); \
            const unsigned ra = (unsigned)DPP_ROR(p4, 4), rb = (unsigned)DPP_ROR(p4, 8), rc = (unsigned)DPP_ROR(p4, 12); \
            const u32x2 pf0 = (u32x2){p4, r4t1 ? ra : rc}, pf1 = (u32x2){rb, r4t1 ? rc : ra}; \
            _Pragma("unroll") for (int dp = 0; dp < 2; ++dp) { \
                Os[2 * dp] = mfma8((u32x2){vf[dp].x, vf[dp].y}, pf0, Os[2 * dp]); Os[2 * dp + 1] = mfma8((u32x2){vf[dp].z, vf[dp].w}, pf0, Os[2 * dp + 1]); \
                Os[2 * dp] = mfma8((u32x2){vf[2 + dp].x, vf[2 + dp].y}, pf1, Os[2 * dp]); Os[2 * dp + 1] = mfma8((u32x2){vf[2 + dp].z, vf[2 + dp].w}, pf1, Os[2 * dp + 1]); } } while (0)
#ifndef SEL_REP
#define SEL_REP 0
#endif
#if SEL_REP
            for (int rep = 0; rep < 2; ++rep) {
#define SELIDX(e_) ((SEL_REP == 2 && rep == 1) ? (e_) : __builtin_amdgcn_readfirstlane(sell[qi * 16 + (e_)]))
#else
            {
#define SELIDX(e_) __builtin_amdgcn_readfirstlane(sell[qi * 16 + (e_)])
#endif
            if (cnt > 0) { const int n0 = SELIDX(0); SEL_LOADK(kA, n0); }
            for (int e = 0; e < cnt; e += 2) {
                const int nA = SELIDX(e);
                const int nB = SELIDX(min(e + 1, cnt - 1));
                SEL_LOADV(vA, nA); SEL_LOADK(kB, nB);
                SEL_COMPUTE(kA, vA, nA);
                if (e + 1 >= cnt) break;
                const int nC = SELIDX(min(e + 2, cnt - 1));
                SEL_LOADV(vA, nB); SEL_LOADK(kA, nC);
                SEL_COMPUTE(kB, vA, nB);
            }
#if SEL_REP
            if (rep == 0) { const float sc0 = GT[tk * 24 + (4 * g + hc) * 3 + 1] / fmaxf(l, 1e-30f);
                if (c < 4) {
#pragma unroll
                    for (int dt = 0; dt < 4; ++dt) { LAS f32x4* sp = (LAS f32x4*)(imp + qi * 256 + c * 64 + 16 * dt + 4 * quad); *sp = *sp + Os[dt] * sc0; } }
                m = -1e30f; l = 0.f;
#pragma unroll
                for (int dt = 0; dt < 4; ++dt) Os[dt] = (f32x4){0.f, 0.f, 0.f, 0.f};
            } else { l = 1e30f;
#pragma unroll
                for (int dt = 0; dt < 4; ++dt) Os[dt] = Os[dt] * 0.f; }
#endif
            }
#undef SEL_LOADK
#undef SEL_LOADV
#undef SEL_COMPUTE
            const float sc = GT[tk * 24 + (4 * g + hc) * 3 + 1] / fmaxf(l, 1e-30f);
            if (c < 4) {
#pragma unroll
                for (int dt = 0; dt < 4; ++dt) { LAS f32x4* sp = (LAS f32x4*)(imp + qi * 256 + c * 64 + 16 * dt + 4 * quad); *sp = *sp + Os[dt] * sc; }
            }
        }
    }
    WAVE_SYNC();
#endif
    float lw[4];
#if EN_WIN
    {
        LANE_VIEW(); LOAD_QF();
        const bf16_t* KW = (const bf16_t*)(ws + WS_KWF) + (size_t)slab * T * 64 + ln_ * 8; const bf16_t* VWT = (const bf16_t*)(ws + WS_VWT) + (size_t)slab * T * 64 + ln_ * 8;
        float m[4];
#pragma unroll
        for (int i = 0; i < 4; ++i) { m[i] = -1e30f; lw[i] = 0.f;
#pragma unroll
            for (int dt = 0; dt < 4; ++dt) O[i][dt] = (f32x4){0.f, 0.f, 0.f, 0.f}; }
        const int g0 = ((t0 - 511 > 0 ? t0 - 511 : 0) & ~31) >> 5, g1 = (t0 + 15) >> 5;
#define WIN_LOAD(kf, vf, grp_) do { const bf16_t* kp_ = KW + (size_t)(grp_) * 2048; const bf16_t* vp_ = VWT + (size_t)(grp_) * 2048; \
            _Pragma("unroll") for (int tl = 0; tl < 2; ++tl) _Pragma("unroll") for (int ks = 0; ks < 2; ++ks) kf[tl][ks] = *(const bf16x8*)(kp_ + (tl * 2 + ks) * 512); \
            _Pragma("unroll") for (int dt = 0; dt < 4; ++dt) vf[dt] = *(const bf16x8*)(vp_ + dt * 512); } while (0)
#define WIN_COMPUTE(kf, vf, grp_) do { const int k0 = 32 * (grp_); const bool inner = (t0 - (k0 + 31)) >= 127 && (t0 + 15 - k0) < 512;     \
            _Pragma("unroll") for (int i = 0; i < 4; ++i) { f32x4 s[2]; \
                _Pragma("unroll") for (int tl = 0; tl < 2; ++tl) { s[tl] = mfma16(kf[tl][0], qf[i][0], (f32x4){0.f, 0.f, 0.f, 0.f}); s[tl] = mfma16(kf[tl][1], qf[i][1], s[tl]); } \
                float mx = -INFINITY; \
                if (inner) { _Pragma("unroll") for (int tl = 0; tl < 2; ++tl) _Pragma("unroll") for (int j = 0; j < 4; ++j) { const float v = (s[tl][j] + biasfar[i]) * LOG2E; s[tl][j] = v; mx = fmaxf(mx, v); } } \
                else { _Pragma("unroll") for (int tl = 0; tl < 2; ++tl) _Pragma("unroll") for (int j = 0; j < 4; ++j) { const int dist = tq - (k0 + 16 * tl + 4 * quad + j); \
                    const float bias = lut[i * 128 + min(max(dist, 0), 127)]; \
                    const float v = (dist >= 0 && dist < 512) ? (s[tl][j] + bias) * LOG2E : -INFINITY; s[tl][j] = v; mx = fmaxf(mx, v); } } \
                mx = qmax(mx); float ps = 0.f; \
                if (__builtin_amdgcn_ballot_w64(mx > m[i]) != 0ull) {   \
                    const float mn = fmaxf(m[i], mx), al = __builtin_amdgcn_exp2f(m[i] - mn); lw[i] *= al; m[i] = mn; \
                    _Pragma("unroll") for (int dt = 0; dt < 4; ++dt) O[i][dt] = O[i][dt] * al; } \
                _Pragma("unroll") for (int tl = 0; tl < 2; ++tl) _Pragma("unroll") for (int j = 0; j < 4; ++j) { const float p = __builtin_amdgcn_exp2f(s[tl][j] - m[i]); s[tl][j] = p; ps += p; } \
                ps = qsum(ps); lw[i] += ps; \
                const bf16x8 pf = pack8(s[0], s[1]); \
                _Pragma("unroll") for (int dt = 0; dt < 4; ++dt) O[i][dt] = mfma16(vf[dt], pf, O[i][dt]); } } while (0)
        {
            bf16x8 kA[2][2], kB[2][2], vA[4], vB[4];
            WIN_LOAD(kA, vA, g0);
            for (int grp = g0; grp <= g1; grp += 2) {
                WIN_LOAD(kB, vB, min(grp + 1, g1));
                WIN_COMPUTE(kA, vA, grp);
                if (grp + 1 > g1) break;
                WIN_LOAD(kA, vA, min(grp + 2, g1));
                WIN_COMPUTE(kB, vB, grp + 1);
            }
        }
#undef WIN_LOAD
#undef WIN_COMPUTE
    }
#else
#pragma unroll
    for (int i = 0; i < 4; ++i) { lw[i] = 1.f;
#pragma unroll
        for (int dt = 0; dt < 4; ++dt) O[i][dt] = (f32x4){0.f, 0.f, 0.f, 0.f}; }
#endif
    LANE_VIEW();
#pragma unroll
    for (int i = 0; i < 4; ++i) { const float sc = GT[tokq * 24 + (4 * g + i) * 3 + 2] / fmaxf(lw[i], 1e-30f);
#pragma unroll
        for (int dt = 0; dt < 4; ++dt) { const f32x4 st = *(const LAS f32x4*)(imp + c * 256 + i * 64 + 16 * dt + 4 * quad);
            *(u32x2*)(CAT + tokq * 1024 + (4 * g + i) * 64 + 16 * dt + 4 * quad) = pk4(st + O[i][dt] * sc); } }
    WAVE_SYNC();
}

__device__ __forceinline__ void grid_bar(unsigned* bar, unsigned k, unsigned G) {
    asm volatile("s_waitcnt vmcnt(0) lgkmcnt(0)" ::: "memory");
    __syncthreads();
    if (threadIdx.x == 0) {
        __builtin_amdgcn_fence(__ATOMIC_RELEASE, "agent");
        asm volatile("s_waitcnt vmcnt(0)" ::: "memory");
        if ((G & 7u) == 0u) {
            const unsigned g = blockIdx.x & 7u;
            const unsigned old = __hip_atomic_fetch_add(bar + 64 * g, 1u, __ATOMIC_RELAXED, __HIP_MEMORY_SCOPE_AGENT);
            if (old + 1u == k * (G >> 3)) {
                const unsigned old2 = __hip_atomic_fetch_add(bar + 64 * 8, 1u, __ATOMIC_RELAXED, __HIP_MEMORY_SCOPE_AGENT);
                if (old2 + 1u == k * 8u) {
#pragma unroll
                    for (int j = 0; j < 8; ++j) __hip_atomic_store(bar + 64 * (9 + j), k, __ATOMIC_RELAXED, __HIP_MEMORY_SCOPE_AGENT);
                }
            }
            while (__hip_atomic_load(bar + 64 * (9 + g), __ATOMIC_RELAXED, __HIP_MEMORY_SCOPE_AGENT) < k) __builtin_amdgcn_s_sleep(1);
        } else {
            __hip_atomic_fetch_add(bar, 1u, __ATOMIC_RELAXED, __HIP_MEMORY_SCOPE_AGENT);
            while (__hip_atomic_load(bar, __ATOMIC_RELAXED, __HIP_MEMORY_SCOPE_AGENT) < k * G) __builtin_amdgcn_s_sleep(1);
        }
        __builtin_amdgcn_fence(__ATOMIC_ACQUIRE, "agent");
        asm volatile("s_waitcnt vmcnt(0)" ::: "memory");
    }
    __syncthreads();
}
typedef const __attribute__((address_space(4))) Params* KP;
__device__ __forceinline__ KP kp_get() { KP k = (KP)__builtin_amdgcn_kernarg_segment_ptr(); asm volatile("" : "+s"(k)); return k; }
#define PIN(i) (kp_get()->in[i])
#define PWS (kp_get()->ws)
#define POUT (kp_get()->out)

__device__ __forceinline__ void phase_prep(LAS unsigned char* lds, int tid, int lane, int wv, int bid, int G) {
    asm volatile("" : "+v"(tid)); lane = tid & 63; wv = __builtin_amdgcn_readfirstlane(tid >> 6);
    const int gw = bid * NWAVES + wv, NGW = G * NWAVES;
    {
        LAS float* vl = (LAS float*)lds; LAS float* red = (LAS float*)(lds + 16384);
        for (int it = bid; it < 288 + 16; it += G) {
            unsigned char* ws = PWS;
            if (it < 288) {
                const int l = it / 144, n0 = (it % 144) * 64; const float* cvec = PIN(1);
                for (int k = tid; k < 2048; k += NTHREADS) { const float cv = cvec[k]; vl[k] = silu_f(cv); }
                __syncthreads();
                float* MOD = (float*)(ws + WS_MOD);
                gemv_item(vl, red, PIN(3) + (size_t)l * D * MODW, MODW, 1024, n0, PIN(4) + (size_t)l * MODW, MOD + (size_t)(l * 2) * MODW, MOD + (size_t)(l * 2 + 1) * MODW, tid);
            } else {
                const int r = it - 288, lj = r >> 2, n0 = (r & 3) * 64; const float* cmp_pe = PIN(12);
                for (int k = tid; k < 4096; k += NTHREADS) vl[k] = k < 2048 ? cmp_pe[(size_t)lj * 2048 + k] : 0.f;
                __syncthreads();
                float* PEB = (float*)(ws + WS_PEB);
                gemv_item(vl, red, PIN(13) + (size_t)lj * 2048 * 256, 256, 2048, n0, PIN(14) + (size_t)lj * 256, PEB + (size_t)lj * 256, nullptr, tid);
            }
        }
        __syncthreads();
        LAS float* scr = (LAS float*)(lds + wv * 8704);
        constexpr int I_UP = 4 * 16 * 176, I_DN = 4 * 44 * 32, I_IN = 2 * 16 * 96, I_OUT = 2 * 16 * 32, I_CW = 4 * 32 * 8;
        constexpr int I_TOT = I_UP + I_DN + I_IN + I_OUT + I_CW;
        const int pl = 8 * ((lane & 15) >> 2) + 4 * ((lane & 31) >> 4) + (lane & 3);
        for (int it = gw; it < I_TOT; it += NGW) {
            int r = it; unsigned char* ws = PWS;
            if (r < I_UP) { const int f = r / (16 * 176), q = r % (16 * 176), kb = q / 176, nb = q % 176; const int n = 32 * nb + pl;
                const int pn = n >> 8, bj = (n >> 7) & 1, j = n & 127; const float* colp = (bj ? PIN(8) : PIN(7)) + (size_t)f * D * FF + 128 * pn + j;
                transpose_item(colp, FF, D, (bf16_t*)(ws + WS_W13) + (size_t)f * FF2 * D, 64 * kb, 32 * nb, scr, lane); continue; }
            r -= I_UP;
            if (r < I_DN) { const int f = r / (44 * 32), q = r % (44 * 32), kb = q / 32, nb = q % 32; const float* colp = PIN(9) + (size_t)f * FF * D + 32 * nb + pl;
                transpose_item(colp, D, FF, (bf16_t*)(ws + WS_W2) + (size_t)f * D * FF, 64 * kb, 32 * nb, scr, lane); continue; }
            r -= I_DN;
            if (r < I_IN) { const int l = r / (16 * 96), q = r % (16 * 96), kb = q / 96, nb = q % 96; const int n = 32 * nb + pl;
                int sc = -1; if (n < 1280) sc = n; else if (n < 2816) sc = n + 24; else if (n < 2840) sc = n - 2816 + 1280; else if (n < 2844) sc = n;
                const float* colp = sc >= 0 ? PIN(10) + (size_t)l * D * DIN + sc : nullptr;
                transpose_item(colp, DIN, D, (bf16_t*)(ws + WS_WIN) + (size_t)l * DINP * D, 64 * kb, 32 * nb, scr, lane); continue; }
            r -= I_IN;
            if (r < I_OUT) { const int l = r / (16 * 32), q = r % (16 * 32), kb = q / 32, nb = q % 32; const float* colp = PIN(11) + (size_t)l * D * D + 32 * nb + pl;
                transpose_item(colp, D, D, (bf16_t*)(ws + WS_WOUT) + (size_t)l * D * D, 64 * kb, 32 * nb, scr, lane); continue; }
            r -= I_OUT;
            { const int lj = r / (32 * 8), q = r % (32 * 8), kb = q / 8, nb = q % 8; const float* colp = PIN(13) + (size_t)lj * 2048 * 256 + 32 * nb + pl;
                transpose_item(colp, 256, 2048, (bf16_t*)(ws + WS_CW1) + (size_t)lj * 256 * 2048, 64 * kb, 32 * nb, scr, lane); }
        }
        { bf16_t* GW = (bf16_t*)(PWS + WS_GW); const float* gws = PIN(18);
          for (int i = bid * NTHREADS + tid; i < 2 * 4 * 128 * 128; i += G * NTHREADS) { const int s = i & 127, t = (i >> 7) & 127; GW[i] = (bf16_t)(s <= t ? f2bf(gws[i]) : 0u); } }
    }
    {
        LAS float* lut = (LAS float*)(lds + LDS_LUT); const float* rel_bias = PIN(2);
        for (int i = tid; i < 8 * 128; i += NTHREADS) { const int h = i >> 7, d = i & 127; int bk;
            if (d < 16) bk = d; else { bk = 16 + (int)(logf((float)d / 16.f) / logf(8.f) * 16.f); bk = bk < 31 ? bk : 31; }
            lut[i] = rel_bias[bk * 8 + h]; }
    }
}

__device__ __forceinline__ void phase_m2(LAS unsigned char* lds, int l, int tid, int bid, int G) {
    asm volatile("" : "+v"(tid));
    unsigned char* ws = PWS;
    if (bid < 32) {
        pg8::Gemm gm{(const bf16_t*)(ws + WS_U) + PC_KC, (const bf16_t*)(ws + WS_CW1) + (size_t)(l * 2) * 256 * 2048, 2048, 16 * PP, 2048, PP * 2, 8, 16, (size_t)64, (size_t)256 * 2048}; pg8::StaticOrder S; S.init(8192, 256, 32, bid);
        EpiBf E{2, (bf16_t*)(ws + WS_HID), (const float*)(ws + WS_PEB) + (size_t)(l * 2) * 256, nullptr, nullptr}; pg8::gemm_phase<EpiBf>(lds, gm, S, E);
    } else {
        for (int it = bid - 32; it < 512; it += G - 32) {
            if (it < 256) {
#if EN_GMLP
                gmlp_item(lds, PWS, PIN(16) + l * 256, PIN(17) + l * 256, (const bf16_t*)(PWS + WS_GW) + (size_t)l * 4 * 128 * 128, PIN(19) + l * 512, it, tid);
#endif
            } else {
#if EN_SSD
                ssd_s1_item(lds, PWS, PIN(20) + (size_t)l * 4 * 768, PIN(21) + l * 768, PIN(23) + l * 4, it - 256, tid);
#endif
            }
        }
        __syncthreads();
        { const int wv = __builtin_amdgcn_readfirstlane(tid >> 6);
          for (int it = (bid - 32) * NWAVES + wv; it < 2048; it += (G - 32) * NWAVES) vt_item(lds + wv * 8704, PWS, it, tid & 63); }
    }
}

__device__ __forceinline__ void phase_m3(int l, int tid, int bid, int G) {
    asm volatile("" : "+v"(tid));
    unsigned char* ws = PWS; const int lane = tid & 63, wv = __builtin_amdgcn_readfirstlane(tid >> 6);
    const bf16_t* HID = (const bf16_t*)(ws + WS_HID); bf16_t* KCMP = (bf16_t*)(ws + WS_KCMP); bf16_t* VCMPT = (bf16_t*)(ws + WS_VCMPT); const float* cmp_w2 = PIN(15);
    for (int rq = bid * NWAVES + wv; rq < 2048; rq += G * NWAVES) {
        const int row0 = 4 * rq, j = row0 >> 12, slab = ((row0 >> 10) & 1) * 2 + ((row0 >> 11) & 1), d = lane;
        const float* w2 = cmp_w2 + (size_t)(l * 2 + j) * 256 * 64 + d; const bf16_t* hr = HID + (size_t)row0 * 256;
        float a[4] = {0.f, 0.f, 0.f, 0.f};
#pragma unroll 2
        for (int k0 = 0; k0 < 256; k0 += 8) {
            bf16x8 hv[4];
#pragma unroll
            for (int r = 0; r < 4; ++r) hv[r] = *(const bf16x8*)(hr + r * 256 + k0);
#pragma unroll
            for (int kk = 0; kk < 8; ++kk) { const float w = w2[(k0 + kk) * 64];
#pragma unroll
                for (int r = 0; r < 4; ++r) a[r] += bf2f((unsigned short)hv[r][kk]) * w; }
        }
#pragma unroll
        for (int r = 0; r < 4; ++r) { const int n = (row0 + r) & 1023; const float av = n < 1023 ? a[r] : 0.f;
            if (j == 0) KCMP[(size_t)slab * 65536 + (size_t)(((n >> 4) * 2 + (d >> 5)) * 64 + ((d >> 3) & 3) * 16 + (n & 15)) * 8 + (d & 7)] = (bf16_t)f2bf(av);
            else { const int w = n & 31, hi = w >> 4, qv = (w & 15) >> 2, e = (w & 3) + 4 * hi;
                VCMPT[(size_t)slab * 65536 + (size_t)(((n >> 5) * 4 + (d >> 4)) * 64 + qv * 16 + (d & 15)) * 8 + e] = (bf16_t)f2bf(av); } }
    }
#if EN_SSD
    const float* ST = (const float*)(ws + WS_STATES); bf16_t* PREV = (bf16_t*)(ws + WS_PREV); const float* CSL = (const float*)(ws + WS_CSL);
    for (int i = bid * NTHREADS + tid; i < 2 * 4 * 8192; i += G * NTHREADS) {
        const int e = i & 8191, h = (i >> 13) & 3, b = i >> 15; float hs = 0.f;
        for (int c0 = 0; c0 < 64; c0 += 8) {
            float sv[8], dc[8];
#pragma unroll
            for (int q = 0; q < 8; ++q) { sv[q] = ST[(((size_t)b * 64 + c0 + q) * 4 + h) * 8192 + e]; dc[q] = CSL[((size_t)b * 64 + c0 + q) * 4 + h]; }
#pragma unroll
            for (int q = 0; q < 8; ++q) { PREV[(((size_t)b * 64 + c0 + q) * 4 + h) * 8192 + e] = (bf16_t)f2bf(hs); hs = __expf(dc[q]) * hs + sv[q]; }
        }
    }
#endif
}

__device__ __forceinline__ void phase_m4(LAS unsigned char* lds, int l, int tid, int bid, int G) {
    asm volatile("" : "+v"(tid));
    const int x = bid & 7, idx = bid >> 3;
    if (G == 256) {
        const int bg = x >> 1, jj = (x & 1) * 32 + idx;
        attn_item(lds, PWS, bg >> 1, bg & 1, jj, tid);
        attn_item(lds, PWS, bg >> 1, bg & 1, 127 - jj, tid);
#if (REP_MASK & 16)
        attn_item(lds, PWS, bg >> 1, bg & 1, jj, tid);
        attn_item(lds, PWS, bg >> 1, bg & 1, 127 - jj, tid);
#endif
    } else {
        for (int it = bid; it < 512; it += G) attn_item(lds, PWS, it >> 8, (it >> 7) & 1, it & 127, tid);
    }
    __syncthreads();
#if EN_SSD
#if (REP_MASK & 32)
    for (int it = bid; it < 256; it += G) ssd_s3_item(lds, PWS, PIN(20) + (size_t)l * 4 * 768, PIN(21) + l * 768, PIN(24) + l * 4, PIN(25) + l * 256, it, tid);
#endif
    for (int it = bid; it < 256; it += G) ssd_s3_item(lds, PWS, PIN(20) + (size_t)l * 4 * 768, PIN(21) + l * 768, PIN(24) + l * 4, PIN(25) + l * 256, it, tid);
#endif
}

__global__ void __launch_bounds__(NTHREADS, 2) mega_fwd(Params p) {
    extern __shared__ __attribute__((aligned(16))) unsigned char lds_raw[];
    LAS unsigned char* lds = (LAS unsigned char*)lds_raw;
    cg::grid_group grid = cg::this_grid();
    const int tid = threadIdx.x, lane = tid & 63, wv = __builtin_amdgcn_readfirstlane(tid >> 6);
    const int G = gridDim.x, bid = blockIdx.x;
    unsigned nbar = 0;
#define GBAR() do { ++nbar; grid_bar((unsigned*)(PWS + WS_BAR), nbar, (unsigned)G); } while (0)

    phase_prep(lds, tid, lane, wv, bid, G);
#if (REP_MASK & 1)
    __syncthreads(); phase_prep(lds, tid, lane, wv, bid, G);
#endif
    GBAR();
    {   int t2 = tid; asm volatile("" : "+v"(t2)); const int lane = t2 & 63, wv = __builtin_amdgcn_readfirstlane(t2 >> 6);
        const float* x_in = PIN(0); const float* MOD = (const float*)(PWS + WS_MOD); bf16_t* Hb = (bf16_t*)(PWS + WS_H);
        for (int row = bid * NWAVES + wv; row < NT; row += G * NWAVES) { const float* mb = MOD + (size_t)(row >= T ? 1 : 0) * MODW; mod_row(x_in + (size_t)row * D, Hb + (size_t)row * D, mb, mb + D, lane); } }
    GBAR();

#pragma unroll 1
    for (int l = 0; l < 2; ++l) {
#pragma unroll 1
        for (int sub = 0; sub < 3; ++sub) {
            const int f = l * 2 + (sub >> 1);
            {
                unsigned char* ws = PWS; const bool mix = sub == 1;
                pg8::Gemm gm{(const bf16_t*)(ws + WS_H), mix ? (const bf16_t*)(ws + WS_WIN) + (size_t)l * DINP * D : (const bf16_t*)(ws + WS_W13) + (size_t)f * FF2 * D, D, D, D, 128, 1 << 30, 1 << 30, 0, 0};
                pg8::StaticOrder S; S.init(NT, mix ? DINP : FF2, G, bid);
                EpiBf E{mix ? 1 : 0, (bf16_t*)(ws + WS_U), PIN(22) + l * 4, (float*)(ws + WS_GATES), (float*)(ws + WS_DT)};
                pg8::gemm_phase<EpiBf>(lds, gm, S, E);
#if (REP_MASK & 2)
                pg8::gemm_phase<EpiBf>(lds, gm, S, E);
#endif
                }
            GBAR();
            if (sub == 1) {
                phase_m2(lds, l, tid, bid, G);
#if (REP_MASK & 4)
                __syncthreads(); phase_m2(lds, l, tid, bid, G);
#endif
                GBAR();
                phase_m3(l, tid, bid, G);
#if (REP_MASK & 8)
                phase_m3(l, tid, bid, G);
#endif
                GBAR();
                phase_m4(lds, l, tid, bid, G);
                GBAR();

            }
            {
                unsigned char* ws = PWS; const bool mix = sub == 1;
                pg8::Gemm gm{mix ? (const bf16_t*)(ws + WS_H) : (const bf16_t*)(ws + WS_U), mix ? (const bf16_t*)(ws + WS_WOUT) + (size_t)l * D * D : (const bf16_t*)(ws + WS_W2) + (size_t)f * D * FF,
                             mix ? D : FF, mix ? D : FF, mix ? D : FF, 128, 1 << 30, 1 << 30, 0, 0};
                pg8::StaticOrder S; S.init(NT, D, G, bid);
                EpiBf E{3, (bf16_t*)(ws + WS_Y), nullptr, nullptr, nullptr}; pg8::gemm_phase<EpiBf>(lds, gm, S, E); }
            GBAR();
            {
                int t2 = tid; asm volatile("" : "+v"(t2)); const int lane = t2 & 63, wv = __builtin_amdgcn_readfirstlane(t2 >> 6);
                float* out = POUT; const float* MOD = (const float*)(PWS + WS_MOD); bf16_t* Hb = (bf16_t*)(PWS + WS_H);
                const float* gam = PIN(5) + (size_t)(l * 3 + sub) * D; const float* bet = PIN(6) + (size_t)(l * 3 + sub) * D;
                const bool last = (l == 1 && sub == 2);
                const int nl = sub == 2 ? l + 1 : l, ns = sub == 2 ? 0 : sub + 1;
                const int NGW2 = G * NWAVES; const float* xin = (l == 0 && sub == 0) ? PIN(0) : (const float*)out; const bf16_t* Yb = (const bf16_t*)(PWS + WS_Y);
                const float* gate = MOD + (size_t)(l * 2) * MODW + sub * 3072 + 2048; const float wgt = sub == 1 ? 1.0f : 0.5f;
                for (int row = bid * NWAVES + wv; row < NT; row += 2 * NGW2) {
                    const int r1 = row + NGW2 < NT ? row + NGW2 : row;
                    const float* mb0 = MOD + (size_t)((last ? 0 : nl) * 2 + (row >= T ? 1 : 0)) * MODW + ns * 3072;
                    const float* mb1 = MOD + (size_t)((last ? 0 : nl) * 2 + (r1 >= T ? 1 : 0)) * MODW + ns * 3072;
                    ln_row2(xin + (size_t)row * D, xin + (size_t)r1 * D, Yb + (size_t)row * D, Yb + (size_t)r1 * D, gate + (row >= T ? MODW : 0), gate + (r1 >= T ? MODW : 0), wgt,
                            out + (size_t)row * D, out + (size_t)r1 * D, gam, bet,
                            last ? nullptr : Hb + (size_t)row * D, last ? nullptr : Hb + (size_t)r1 * D, mb0, mb0 + D, mb1, mb1 + D, lane);
                }
            }
            if (!(l == 1 && sub == 2)) GBAR();
#if (REP_MASK & 64)
            for (int rep = 0; rep < 5; ++rep) GBAR();
#endif
        }
    }
    grid.sync();
}

extern "C" void kernel_launch(void* const* d_in, const int* in_sizes, int n_in, void* d_out, int out_size, void* d_ws, size_t ws_size, hipStream_t stream) {
    static int grid = 0;
    if (grid == 0) {
        int dev = 0, cus = 0, per_cu = 0;
        hipGetDevice(&dev);
        hipDeviceGetAttribute(&cus, hipDeviceAttributeMultiprocessorCount, dev);
        hipFuncSetAttribute((const void*)mega_fwd, hipFuncAttributeMaxDynamicSharedMemorySize, LDS_BYTES);
        if (hipOccupancyMaxActiveBlocksPerMultiprocessor(&per_cu, (const void*)mega_fwd, NTHREADS, LDS_BYTES) != hipSuccess || per_cu < 1) { fprintf(stderr, "occupancy query failed (%d)\n", per_cu); per_cu = 1; }
        (void)hipGetLastError();
        grid = cus * per_cu;
        if (n_in != 26 || ws_size < WS_END) { fprintf(stderr, "kernel_launch: unexpected n_in %d / ws_size %zu\n", n_in, ws_size); grid = -1; }
    }
    if (grid < 0) return;
    Params p{};
    for (int i = 0; i < 26; ++i) p.in[i] = (const float*)d_in[i];
    p.out = (float*)d_out; p.ws = (unsigned char*)d_ws;
    (void)hipMemsetAsync((char*)d_ws + WS_BAR, 0, 8192, stream);
    void* args[] = {&p};
    hipError_t e = hipLaunchCooperativeKernel((const void*)mega_fwd, dim3(grid), dim3(NTHREADS), args, LDS_BYTES, stream);
    if (e != hipSuccess) fprintf(stderr, "cooperative launch failed: %s (grid %d)\n", hipGetErrorString(e), grid);
}
```

```cpp
#include <hip/hip_runtime.h>
#include <hip/hip_cooperative_groups.h>
#include <cstdio>
#include <cstdint>
namespace cg = cooperative_groups;

#ifndef EN_GMLP
#define EN_GMLP 1
#endif
#ifndef EN_SSD
#define EN_SSD 1
#endif
#ifndef EN_CMP
#define EN_CMP 1
#endif
#ifndef EN_SEL
#define EN_SEL 1
#endif
#ifndef EN_WIN
#define EN_WIN 1
#endif
#ifndef REP_MASK
#define REP_MASK 0
#endif
#ifndef EN_MIXER
#define EN_MIXER 1
#endif

#define LAS __attribute__((address_space(3)))
#define DPP_ROR(x, n) __builtin_amdgcn_update_dpp(0, (int)(x), 0x120 + (n), 0xF, 0xF, true)
typedef unsigned short bf16_t;
typedef short bf16x8 __attribute__((ext_vector_type(8)));
typedef short bf16x4 __attribute__((ext_vector_type(4)));
typedef float f32x4 __attribute__((ext_vector_type(4)));
typedef float f32x2 __attribute__((ext_vector_type(2)));
typedef unsigned u32x4 __attribute__((ext_vector_type(4)));
typedef unsigned u32x2 __attribute__((ext_vector_type(2)));

constexpr int D = 1024, NBATCH = 2, T = 16384, NT = NBATCH * T, FF = 2816, FF2 = 2 * FF, DINP = 3072, DIN = 2844;
constexpr int MODW = 9216;
constexpr float ALPHA = 1.41421356237309515f;
constexpr float LN_EPS = 1e-5f;
constexpr float LOG2E = 1.4426950408889634f;
constexpr int NWAVES = 8, NTHREADS = 512;
constexpr int LDS_BYTES = 155648;
constexpr int LDS_LUT = 147456;

constexpr size_t MiB = 1u << 20;
constexpr size_t WS_MOD = 0;
constexpr size_t WS_PEB = 512 * 1024;
constexpr size_t WS_CSL = 768 * 1024;
constexpr size_t WS_BAR = 896 * 1024;
constexpr size_t WS_W13 = 1 * MiB;
constexpr size_t WS_W2 = 45 * MiB;
constexpr size_t WS_WIN = 67 * MiB;
constexpr size_t WS_WOUT = 79 * MiB;
constexpr size_t WS_CW1 = 83 * MiB;
constexpr size_t WS_GW = 87 * MiB;
constexpr size_t WS_H = 88 * MiB;
constexpr size_t WS_U = 152 * MiB;
constexpr int PP = 3072;
constexpr int PC_Q = 0, PC_KC = 512, PC_VC = 640, PC_KS = 768, PC_VS = 896, PC_KW = 1024, PC_VW = 1152, PC_U = 1280, PC_V = 1536, PC_Z = 1792, PC_X = 2048, PC_B = 2304, PC_C = 2560;
constexpr size_t WS_MISC = WS_U + 192 * MiB;
constexpr size_t WS_HID = WS_MISC;
constexpr size_t WS_KCMP = WS_MISC + 4 * MiB;
constexpr size_t WS_VCMPT = WS_KCMP + 512 * 1024;
constexpr size_t WS_GATES = WS_MISC + 5 * MiB;
constexpr size_t WS_DT = WS_MISC + 8 * MiB;
constexpr size_t WS_CS = WS_DT + 512 * 1024;
constexpr size_t WS_STATES = WS_MISC + 9 * MiB;
constexpr size_t WS_PREV = WS_MISC + 25 * MiB;
constexpr size_t WS_VST = WS_MISC + 33 * MiB;
constexpr size_t WS_VWT = WS_MISC + 41 * MiB;
constexpr size_t WS_KSF = WS_MISC + 49 * MiB;
constexpr size_t WS_KWF = WS_MISC + 57 * MiB;
constexpr size_t WS_Y = WS_MISC + 65 * MiB;
constexpr size_t WS_END = WS_MISC + 129 * MiB;

struct Params {
    const float* in[26];
    float* out;
    unsigned char* ws;
};

__device__ __forceinline__ unsigned pk2(float lo, float hi) { unsigned r; asm("v_cvt_pk_bf16_f32 %0, %1, %2" : "=v"(r) : "v"(lo), "v"(hi)); return r; }
__device__ __forceinline__ unsigned f2bf(float f) { return pk2(f, 0.f) & 0xffffu; }
__device__ __forceinline__ float bf2f(unsigned short b) { return __builtin_bit_cast(float, ((unsigned)b) << 16); }
__device__ __forceinline__ u32x2 pk4(f32x4 v) { u32x2 r; r.x = pk2(v.x, v.y); r.y = pk2(v.z, v.w); return r; }
__device__ __forceinline__ float silu_f(float x) { return x * __builtin_amdgcn_rcpf(1.f + __builtin_amdgcn_exp2f(-LOG2E * x)); }
__device__ __forceinline__ float sigmoid_f(float x) { return __builtin_amdgcn_rcpf(1.f + __builtin_amdgcn_exp2f(-LOG2E * x)); }
__device__ __forceinline__ float gelu_tanh(float x) {
    const float y = 0.7978845608028654f * (x + 0.044715f * x * x * x); return x * __builtin_amdgcn_rcpf(1.f + __builtin_amdgcn_exp2f(-2.f * LOG2E * y)); }
__device__ __forceinline__ float softplus_f(float x) { return fmaxf(x, 0.f) + log1pf(__expf(-fabsf(x))); }
__device__ __forceinline__ float wave_sum(float v) {
#pragma unroll
    for (int o = 1; o < 64; o <<= 1) v += __shfl_xor(v, o);
    return v;
}
__device__ __forceinline__ void swap16(unsigned& a, unsigned& b) { asm volatile("s_nop 1\n\tv_permlane16_swap_b32 %0, %1\n\ts_nop 1" : "+v"(a), "+v"(b)); }
__device__ __forceinline__ void swap32(unsigned& a, unsigned& b) { asm volatile("s_nop 1\n\tv_permlane32_swap_b32 %0, %1\n\ts_nop 1" : "+v"(a), "+v"(b)); }
__device__ __forceinline__ float qmax(float v) {
    unsigned a = __builtin_bit_cast(unsigned, v), b = a; swap16(a, b); v = fmaxf(__builtin_bit_cast(float, a), __builtin_bit_cast(float, b));
    a = __builtin_bit_cast(unsigned, v); b = a; swap32(a, b); return fmaxf(__builtin_bit_cast(float, a), __builtin_bit_cast(float, b)); }
__device__ __forceinline__ float qsum(float v) {
    unsigned a = __builtin_bit_cast(unsigned, v), b = a; swap16(a, b); v = __builtin_bit_cast(float, a) + __builtin_bit_cast(float, b);
    a = __builtin_bit_cast(unsigned, v); b = a; swap32(a, b); return __builtin_bit_cast(float, a) + __builtin_bit_cast(float, b); }
__device__ __forceinline__ float wave_fsum(float v) {
    v += __builtin_bit_cast(float, __builtin_amdgcn_update_dpp(0, __builtin_bit_cast(int, v), 0xB1, 0xF, 0xF, true));
    v += __builtin_bit_cast(float, __builtin_amdgcn_update_dpp(0, __builtin_bit_cast(int, v), 0x4E, 0xF, 0xF, true));
    v += __builtin_bit_cast(float, __builtin_amdgcn_update_dpp(0, __builtin_bit_cast(int, v), 0x141, 0xF, 0xF, true));
    v += __builtin_bit_cast(float, __builtin_amdgcn_update_dpp(0, __builtin_bit_cast(int, v), 0x140, 0xF, 0xF, true));
    return qsum(v); }
__device__ __forceinline__ unsigned wave_umax(unsigned v) {
    v = max(v, (unsigned)__builtin_amdgcn_update_dpp(0, (int)v, 0xB1, 0xF, 0xF, true));
    v = max(v, (unsigned)__builtin_amdgcn_update_dpp(0, (int)v, 0x4E, 0xF, 0xF, true));
    v = max(v, (unsigned)__builtin_amdgcn_update_dpp(0, (int)v, 0x141, 0xF, 0xF, true));
    v = max(v, (unsigned)__builtin_amdgcn_update_dpp(0, (int)v, 0x140, 0xF, 0xF, true));
    unsigned a = v, b = v; swap16(a, b); v = max(a, b); a = v; b = v; swap32(a, b); return max(a, b); }
#define WAVE_SYNC() do { asm volatile("s_waitcnt lgkmcnt(0)" ::: "memory"); __builtin_amdgcn_wave_barrier(); } while (0)
__device__ __forceinline__ unsigned pk_fp8x4(float a, float b, float c, float d) { int r = __builtin_amdgcn_cvt_pk_fp8_f32(a, b, 0, false); r = __builtin_amdgcn_cvt_pk_fp8_f32(c, d, r, true); return (unsigned)r; }
__device__ __forceinline__ u32x2 bf8_to_fp8(bf16x8 v, float sc) { u32x2 r;
    r.x = pk_fp8x4(bf2f((unsigned short)v[0]) * sc, bf2f((unsigned short)v[1]) * sc, bf2f((unsigned short)v[2]) * sc, bf2f((unsigned short)v[3]) * sc);
    r.y = pk_fp8x4(bf2f((unsigned short)v[4]) * sc, bf2f((unsigned short)v[5]) * sc, bf2f((unsigned short)v[6]) * sc, bf2f((unsigned short)v[7]) * sc); return r; }
__device__ __forceinline__ f32x4 mfma8(u32x2 a, u32x2 b, f32x4 c) { return __builtin_amdgcn_mfma_f32_16x16x32_fp8_fp8(__builtin_bit_cast(long, a), __builtin_bit_cast(long, b), c, 0, 0, 0); }
__device__ __forceinline__ f32x4 mfma16(bf16x8 a, bf16x8 b, f32x4 c) { return __builtin_amdgcn_mfma_f32_16x16x32_bf16(a, b, c, 0, 0, 0); }
__device__ __forceinline__ bf16x8 cat44(bf16x4 lo, bf16x4 hi) { bf16x8 r; r[0] = lo[0]; r[1] = lo[1]; r[2] = lo[2]; r[3] = lo[3]; r[4] = hi[0]; r[5] = hi[1]; r[6] = hi[2]; r[7] = hi[3]; return r; }
__device__ __forceinline__ bf16x8 pack8(f32x4 a, f32x4 b) { u32x4 r; r.x = pk2(a.x, a.y); r.y = pk2(a.z, a.w); r.z = pk2(b.x, b.y); r.w = pk2(b.z, b.w); return __builtin_bit_cast(bf16x8, r); }

namespace pg8 {
constexpr int BM = 256, BK = 64, HALF = 128, HTB = HALF * BK * 2, STAGE_BYTES = 8 * HTB, NXCD = 8, WGM = 8;
__host__ __device__ __forceinline__ int lds_byte(int r, int c) { const int st = (r >> 4) * 2 + (c >> 5), rr = r & 15, cc = c & 31, ob = rr * 64 + cc * 2; return st * 1024 + (ob ^ (((ob >> 9) & 1) << 5)); }
__host__ __device__ __forceinline__ void stage_rc(int b, int& R, int& C) { const int st = b / 1024, sb = b % 1024, swz = sb ^ (((sb >> 9) & 1) << 5); R = (st >> 1) * 16 + swz / 64; C = (st & 1) * 32 + (swz % 64) / 2; }
struct Unit { int pm, pn; };
struct Gemm { const bf16_t* A; const bf16_t* Bt; int K, lda, ldb, kstepA, adiv, bdiv; size_t astride, bstride; };
struct StaticOrder {
    int nM, nN, nwg, G, c;
    __device__ void init(int M, int N, int G_, int c_) { nM = M / BM; nN = N / BM; nwg = nM * nN; G = G_; c = c_; }
    __device__ bool next(int i, Unit& u) const {
        const long L = (long)i * G + c; if (L >= nwg) return false;
        int wgid = (int)L; { const int q = nwg / NXCD, r = nwg % NXCD, xcd = wgid % NXCD, off = wgid / NXCD; wgid = (xcd < r ? xcd * (q + 1) : r * (q + 1) + (xcd - r) * q) + off; }
        const int nig = WGM * nN, gid = wgid / nig, fm = gid * WGM, gsz = (nM - fm) < WGM ? (nM - fm) : WGM;
        u.pm = fm + ((wgid % nig) % gsz); u.pn = (wgid % nig) / gsz; return true;
    }
};
template <class Epi>
__device__ __forceinline__ void gemm_phase(LAS unsigned char* lds, const Gemm g, const StaticOrder& S, const Epi& E) {
    int tid = threadIdx.x; asm volatile("" : "+v"(tid));
    const int wid = __builtin_amdgcn_readfirstlane(tid >> 6), lane = tid & 63, wr = wid >> 2, wc = wid & 3, fr = lane & 15, fq = lane >> 4;
    const int K = g.K, nt = K / BK;
    unsigned voffA[2], voffB[2];
#pragma unroll
    for (int i = 0; i < 2; ++i) { int R, C; stage_rc(tid * 16 + i * 8192, R, C); voffA[i] = (unsigned)(R * g.lda + C) * 2u; voffB[i] = (unsigned)(R * g.ldb + C) * 2u; }
    const size_t kstep = (size_t)(BK * 2), kstepA = (size_t)g.kstepA;
    const size_t hstepA = (size_t)HALF * g.lda * 2, hstepB = (size_t)HALF * g.ldb * 2;
    const size_t tstepA = 2 * hstepA, tstepB = 2 * hstepB;
    const unsigned ldsw = (unsigned)wid * 1024u;
    const int aoff = lds_byte(wr * 64 + fr, fq * 8), boff = lds_byte(wc * 32 + fr, fq * 8);
#define PG8_SA(b, h) (((b) * 2 + (h)) * HTB)
#define PG8_SB(b, h) ((4 + (b) * 2 + (h)) * HTB)
#define PG8_STAGE(bufoff, gbase, voff) do { _Pragma("unroll") for (int _i = 0; _i < 2; ++_i) \
        __builtin_amdgcn_global_load_lds((const unsigned*)((const char*)(gbase) + (voff)[_i]), (LAS unsigned*)(lds + (bufoff) + ldsw + _i * 8192), 16, 0, 0); } while (0)
#define PG8_LDA(dst, b, h) do { _Pragma("unroll") for (int m = 0; m < 4; ++m) _Pragma("unroll") for (int k = 0; k < 2; ++k) dst[m][k] = *(const LAS bf16x8*)(lds + PG8_SA(b, h) + aoff + m * 2048 + k * 1024); } while (0)
#define PG8_LDB(dst, b, h) do { _Pragma("unroll") for (int n = 0; n < 2; ++n) _Pragma("unroll") for (int k = 0; k < 2; ++k) dst[n][k] = *(const LAS bf16x8*)(lds + PG8_SB(b, h) + boff + n * 2048 + k * 1024); } while (0)
#define PG8_MMA(ai, bj, At, Bt) do { __builtin_amdgcn_s_setprio(1); _Pragma("unroll") for (int m = 0; m < 4; ++m) _Pragma("unroll") for (int n = 0; n < 2; ++n) _Pragma("unroll") for (int k = 0; k < 2; ++k) \
        acc[ai][bj][m][n] = __builtin_amdgcn_mfma_f32_16x16x32_bf16(Bt[n][k], At[m][k], acc[ai][bj][m][n], 0, 0, 0); __builtin_amdgcn_s_setprio(0); } while (0)
#define PG8_WAIT_V(n) asm volatile("s_waitcnt vmcnt(" #n ")" ::: "memory")
#define PG8_WAIT_L(n) asm volatile("s_waitcnt lgkmcnt(" #n ")" ::: "memory")
#define PG8_BAR __builtin_amdgcn_s_barrier()
#define PG8_SCHED __builtin_amdgcn_sched_barrier(0)
    Unit cur, nxt; int ui = 0;
    if (!S.next(0, cur)) return;
    f32x4 acc[2][2][4][2];
#pragma unroll
    for (int a = 0; a < 2; ++a)
#pragma unroll
        for (int b = 0; b < 2; ++b)
#pragma unroll
            for (int m = 0; m < 4; ++m)
#pragma unroll
                for (int n = 0; n < 2; ++n) acc[a][b][m][n] = (f32x4){0.f, 0.f, 0.f, 0.f};
    bf16x8 At[4][2], B0[2][2], B1[2][2];
    const char* cA = (const char*)(g.A + (size_t)(cur.pm / g.adiv) * g.astride) + (size_t)(cur.pm % g.adiv) * tstepA; const char* cB = (const char*)(g.Bt + (size_t)(cur.pm / g.bdiv) * g.bstride) + (size_t)cur.pn * tstepB;
    PG8_STAGE(PG8_SB(0, 0), cB, voffB); PG8_STAGE(PG8_SB(0, 1), cB + hstepB, voffB); PG8_STAGE(PG8_SA(0, 0), cA, voffA); PG8_STAGE(PG8_SA(0, 1), cA + hstepA, voffA);
    if (wr == 1) PG8_BAR;
    PG8_WAIT_V(2); PG8_BAR;
    PG8_STAGE(PG8_SB(1, 0), cB + kstep, voffB); PG8_STAGE(PG8_SA(1, 0), cA + kstepA, voffA); PG8_STAGE(PG8_SB(1, 1), cB + hstepB + kstep, voffB);
    PG8_WAIT_V(6); PG8_BAR;
    for (;;) {
        const bool has_next = S.next(ui + 1, nxt);
        const char* nA = has_next ? (const char*)(g.A + (size_t)(nxt.pm / g.adiv) * g.astride) + (size_t)(nxt.pm % g.adiv) * tstepA : cA;
        const char* nB = has_next ? (const char*)(g.Bt + (size_t)(nxt.pm / g.bdiv) * g.bstride) + (size_t)nxt.pn * tstepB : cB;
        for (int t = 0; t < nt; t += 2) {
            const bool last = (t == nt - 2);
            const char* a1 = cA + (size_t)(t + 1) * kstepA;
            const char* a2 = last ? nA : cA + (size_t)(t + 2) * kstepA; const char* b2 = last ? nB : cB + (size_t)(t + 2) * kstep;
            const char* a3 = a2 + kstepA; const char* b3 = b2 + kstep;
            PG8_LDB(B0, 0, 0); PG8_LDB(B1, 0, 1); PG8_SCHED; PG8_LDA(At, 0, 0); PG8_STAGE(PG8_SA(1, 1), a1 + hstepA, voffA);
            PG8_WAIT_V(8); PG8_WAIT_L(0); PG8_BAR; PG8_MMA(0, 0, At, B0); PG8_MMA(0, 1, At, B1); PG8_BAR; PG8_SCHED;
            PG8_LDA(At, 0, 1); PG8_STAGE(PG8_SB(0, 0), b2, voffB); PG8_STAGE(PG8_SB(0, 1), b2 + hstepB, voffB); PG8_STAGE(PG8_SA(0, 0), a2, voffA);
            PG8_WAIT_V(8); PG8_WAIT_L(0); PG8_BAR; PG8_MMA(1, 0, At, B0); PG8_MMA(1, 1, At, B1); PG8_BAR; PG8_SCHED;
            PG8_LDB(B0, 1, 0); PG8_LDB(B1, 1, 1); PG8_SCHED; PG8_LDA(At, 1, 0); PG8_STAGE(PG8_SA(0, 1), a2 + hstepA, voffA);
            PG8_WAIT_V(8); PG8_WAIT_L(0); PG8_BAR; PG8_MMA(0, 0, At, B0); PG8_MMA(0, 1, At, B1); PG8_BAR; PG8_SCHED;
            PG8_LDA(At, 1, 1); PG8_STAGE(PG8_SB(1, 0), b3, voffB); PG8_STAGE(PG8_SB(1, 1), b3 + hstepB, voffB); PG8_STAGE(PG8_SA(1, 0), a3, voffA);
            PG8_WAIT_V(8); PG8_WAIT_L(0); PG8_BAR; PG8_MMA(1, 0, At, B0); PG8_MMA(1, 1, At, B1); PG8_BAR; PG8_SCHED;
        }
        if (wr == 0) PG8_BAR;
        E(acc, cur, wr, wc, fr, fq);
#if (REP_MASK & 512)
        asm volatile("" ::: "memory"); E(acc, cur, wr, wc, fr, fq);
#endif
        if (!has_next) break;
#pragma unroll
        for (int a = 0; a < 2; ++a)
#pragma unroll
            for (int b = 0; b < 2; ++b)
#pragma unroll
                for (int m = 0; m < 4; ++m)
#pragma unroll
                    for (int n = 0; n < 2; ++n) acc[a][b][m][n] = (f32x4){0.f, 0.f, 0.f, 0.f};
        cur = nxt; cA = nA; cB = nB; ++ui;
        if (wr == 1) PG8_BAR;
    }
    PG8_WAIT_V(0);
    PG8_BAR;
#undef PG8_SA
#undef PG8_SB
#undef PG8_STAGE
#undef PG8_LDA
#undef PG8_LDB
#undef PG8_MMA
#undef PG8_WAIT_V
#undef PG8_WAIT_L
#undef PG8_BAR
#undef PG8_SCHED
}
}
typedef f32x4 AccT[2][2][4][2];

struct EpiBf {
    int mode; bf16_t* O; const float* aux; float* gates; float* dtp;
    __device__ __forceinline__ void operator()(const AccT& acc, const pg8::Unit& u, int wr, int wc, int fr, int fq) const {
        const int row0 = u.pm * 256 + wr * 64 + fr;
        if (mode == 0) {
            const int col0 = u.pn * 128 + wc * 32 + 8 * fq;
#pragma unroll
            for (int ai = 0; ai < 2; ++ai)
#pragma unroll
                for (int m = 0; m < 4; ++m) { u32x4 w;
#pragma unroll
                    for (int n = 0; n < 2; ++n) { const f32x4 gg = acc[ai][0][m][n], vv = acc[ai][1][m][n]; f32x4 o;
#pragma unroll
                        for (int e = 0; e < 4; ++e) o[e] = silu_f(gg[e]) * vv[e];
                        const u32x2 pkd = pk4(o); if (n == 0) { w.x = pkd.x; w.y = pkd.y; } else { w.z = pkd.x; w.w = pkd.y; } }
                    *(u32x4*)(O + (size_t)(row0 + ai * 128 + m * 16) * FF + col0) = w; }
        } else if (mode == 2) {
            const int col0 = wc * 32 + 8 * fq; const float* bp = aux + (u.pm >= 16 ? 256 : 0);
#pragma unroll
            for (int bj = 0; bj < 2; ++bj) { const f32x4 bv0 = *(const f32x4*)(bp + col0 + bj * 128), bv1 = *(const f32x4*)(bp + col0 + bj * 128 + 4);
#pragma unroll
                for (int ai = 0; ai < 2; ++ai)
#pragma unroll
                    for (int m = 0; m < 4; ++m) { f32x4 o0, o1;
#pragma unroll
                        for (int e = 0; e < 4; ++e) { o0[e] = gelu_tanh(acc[ai][bj][m][0][e] + bv0[e]); o1[e] = gelu_tanh(acc[ai][bj][m][1][e] + bv1[e]); }
                        const u32x2 p0 = pk4(o0), p1 = pk4(o1); u32x4 w; w.x = p0.x; w.y = p0.y; w.z = p1.x; w.w = p1.y;
                        *(u32x4*)(O + (size_t)(row0 + ai * 128 + m * 16) * 256 + col0 + bj * 128) = w; } }
        } else if (mode == 3 || u.pn < 11) {
            const int pn = u.pn; const int col0 = pn * 256 + wc * 32 + 8 * fq; const bool isq = mode == 1 && pn < 2, isg = mode == 1 && (pn == 5 || pn == 6); const int pitch = mode == 3 ? D : PP;
#pragma unroll
            for (int ai = 0; ai < 2; ++ai)
#pragma unroll
                for (int m = 0; m < 4; ++m) { bf16_t* rowp = O + (size_t)(row0 + ai * 128 + m * 16) * pitch + col0;
#pragma unroll
                    for (int bj = 0; bj < 2; ++bj) { u32x4 w;
#pragma unroll
                        for (int n = 0; n < 2; ++n) { f32x4 v = acc[ai][bj][m][n];
                            if (isq) v = v * 0.125f;
                            if (isg) {
#pragma unroll
                                for (int e = 0; e < 4; ++e) v[e] = gelu_tanh(v[e]); }
                            const u32x2 pkd = pk4(v); if (n == 0) { w.x = pkd.x; w.y = pkd.y; } else { w.z = pkd.x; w.w = pkd.y; } }
                        *(u32x4*)(rowp + bj * 128) = w; } }
        } else {
            if (wc == 0) {
                const f32x4 db = *(const f32x4*)aux;
#pragma unroll
                for (int ai = 0; ai < 2; ++ai)
#pragma unroll
                    for (int m = 0; m < 4; ++m) { const size_t row = (size_t)(row0 + ai * 128 + m * 16);
#pragma unroll
                        for (int n = 0; n < 2; ++n) { const int lc = 8 * fq + 4 * n; const f32x4 v = acc[ai][0][m][n];
                            if (lc < 24) { f32x4 o;
#pragma unroll
                                for (int e = 0; e < 4; ++e) o[e] = sigmoid_f(v[e]);
                                *(f32x4*)(gates + row * 24 + lc) = o; }
                            else if (lc == 24) { f32x4 o;
#pragma unroll
                                for (int e = 0; e < 4; ++e) o[e] = softplus_f(v[e] + db[e]);
                                *(f32x4*)(dtp + row * 4) = o; } } }
            }
        }
    }
};

__device__ __forceinline__ void transpose_item(const float* colp, int ldsrc, int K, bf16_t* WT, int k0, int n0, LAS float* scr, int lane) {
    float tv[32];
#pragma unroll
    for (int i = 0; i < 32; ++i) { const int kk = 2 * i + (lane >> 5); tv[i] = colp ? colp[(size_t)(k0 + kk) * ldsrc] : 0.f; }
#pragma unroll
    for (int i = 0; i < 32; ++i) { const int kk = 2 * i + (lane >> 5); scr[kk * 33 + (lane & 31)] = tv[i]; }
    WAVE_SYNC();
    const int c = lane & 7;
#pragma unroll
    for (int j = 0; j < 4; ++j) { const int n = (lane >> 3) + 8 * j; const LAS float* s = scr + (8 * c) * 33 + n;
        u32x4 o; o.x = pk2(s[0 * 33], s[1 * 33]); o.y = pk2(s[2 * 33], s[3 * 33]); o.z = pk2(s[4 * 33], s[5 * 33]); o.w = pk2(s[6 * 33], s[7 * 33]);
        *(u32x4*)(WT + (size_t)(n0 + n) * K + k0 + 8 * c) = o; }
    WAVE_SYNC();
}
__device__ __forceinline__ void gemv_item(LAS float* vl, LAS float* red, const float* W, int ldw, int K, int n0, const float* bias, float* out0, float* out1, int tid) {
    const int lane = tid & 63, wv = tid >> 6, kq = K / 8;
    float a0 = 0.f, a1 = 0.f; const float* wp = W + (size_t)(wv * kq) * ldw + n0 + lane;
#pragma unroll 8
    for (int k = 0; k < kq; ++k) { const float w = wp[(size_t)k * ldw]; a0 += vl[wv * kq + k] * w; a1 += vl[K + wv * kq + k] * w; }
    red[(wv * 64 + lane) * 2] = a0; red[(wv * 64 + lane) * 2 + 1] = a1;
    __syncthreads();
    if (tid < 128) { const int n = tid & 63, bb = tid >> 6; float s = 0.f;
#pragma unroll
        for (int w = 0; w < 8; ++w) s += red[(w * 64 + n) * 2 + bb];
        s += bias[n0 + n]; if (bb == 0) out0[n0 + n] = s; else if (out1) out1[n0 + n] = s; }
    __syncthreads();
}

__device__ __forceinline__ void ln_row2(const float* xi0, const float* xi1, const bf16_t* y0, const bf16_t* y1, const float* gt0, const float* gt1, float wgt,
                                        float* x0, float* x1, const float* gam, const float* bet, bf16_t* h0, bf16_t* h1,
                                        const float* sh0, const float* sc0, const float* sh1, const float* sc1, int lane) {
    f32x4 v[2][4]; u32x2 yr[2][4]; float s[2] = {0.f, 0.f};
#pragma unroll
    for (int j = 0; j < 4; ++j) { v[0][j] = __builtin_nontemporal_load((const f32x4*)(xi0 + 256 * j + 4 * lane)); v[1][j] = __builtin_nontemporal_load((const f32x4*)(xi1 + 256 * j + 4 * lane));
        yr[0][j] = __builtin_nontemporal_load((const u32x2*)(y0 + 256 * j + 4 * lane)); yr[1][j] = __builtin_nontemporal_load((const u32x2*)(y1 + 256 * j + 4 * lane)); }
#pragma unroll
    for (int j = 0; j < 4; ++j) { const int col = 256 * j + 4 * lane;
#pragma unroll
        for (int r = 0; r < 2; ++r) { const f32x4 gv = *(const f32x4*)((r ? gt1 : gt0) + col); const u32x2 q = yr[r][j];
            f32x4 yy; yy.x = bf2f(q.x & 0xffff); yy.y = bf2f(q.x >> 16); yy.z = bf2f(q.y & 0xffff); yy.w = bf2f(q.y >> 16);
            v[r][j] = v[r][j] * ALPHA + (gv + 1.f) * wgt * yy; } }
#pragma unroll
    for (int r = 0; r < 2; ++r)
#pragma unroll
        for (int j = 0; j < 4; ++j) s[r] += (v[r][j].x + v[r][j].y) + (v[r][j].z + v[r][j].w);
    float mean[2], rstd[2];
#pragma unroll
    for (int r = 0; r < 2; ++r) { mean[r] = wave_fsum(s[r]) * (1.f / D); float s2 = 0.f;
#pragma unroll
        for (int j = 0; j < 4; ++j) { v[r][j] = v[r][j] - mean[r]; s2 += (v[r][j].x * v[r][j].x + v[r][j].y * v[r][j].y) + (v[r][j].z * v[r][j].z + v[r][j].w * v[r][j].w); }
        rstd[r] = rsqrtf(wave_fsum(s2) * (1.f / D) + LN_EPS); }
#pragma unroll
    for (int j = 0; j < 4; ++j) { const int col = 256 * j + 4 * lane; const f32x4 g = *(const f32x4*)(gam + col), be = *(const f32x4*)(bet + col);
#pragma unroll
        for (int r = 0; r < 2; ++r) { f32x4 y = v[r][j] * rstd[r] * g + be; __builtin_nontemporal_store(y, (f32x4*)((r ? x1 : x0) + col));
            if (h0) { const f32x4 sc = *(const f32x4*)((r ? sc1 : sc0) + col), sh = *(const f32x4*)((r ? sh1 : sh0) + col); *(u32x2*)((r ? h1 : h0) + col) = pk4(y * (1.f + sc) + sh); } } }
}
__device__ __forceinline__ void mod_row(const float* xrow, bf16_t* hrow, const float* shift, const float* scale, int lane) {
#pragma unroll
    for (int j = 0; j < 4; ++j) { const int col = 256 * j + 4 * lane; const f32x4 y = __builtin_nontemporal_load((const f32x4*)(xrow + col)), sc = *(const f32x4*)(scale + col), sh = *(const f32x4*)(shift + col);
        *(u32x2*)(hrow + col) = pk4(y * (1.f + sc) + sh); }
}

__device__ __forceinline__ bf16x8 gather8(const LAS bf16_t* p, int stride) { bf16x8 r;
#pragma unroll
    for (int e = 0; e < 8; ++e) r[e] = (short)p[e * stride];
    return r; }
__device__ __forceinline__ bf16x8 gather44(const LAS bf16_t* p, int stride) { bf16x8 r;
#pragma unroll
    for (int e = 0; e < 4; ++e) { r[e] = (short)p[e * stride]; r[4 + e] = (short)p[(16 + e) * stride]; }
    return r; }
__device__ __forceinline__ void conv_tok8(const bf16_t* colbase  , int tpos, const float (&w)[4][8], const float (&bi)[8], float* a) {
#pragma unroll
    for (int e = 0; e < 8; ++e) a[e] = bi[e];
#pragma unroll
    for (int j = 0; j < 4; ++j) { if (tpos - 3 + j >= 0) { const bf16x8 rv = *(const bf16x8*)(colbase + (ptrdiff_t)(j - 3) * PP);
#pragma unroll
            for (int e = 0; e < 8; ++e) a[e] += w[j][e] * bf2f((unsigned short)rv[e]); } }
#pragma unroll
    for (int e = 0; e < 8; ++e) a[e] = silu_f(a[e]);
}
__device__ __forceinline__ void load_convw(const float* convw, const float* convb, int cidx, float (&w)[4][8], float (&bi)[8]) {
#pragma unroll
    for (int e = 0; e < 8; ++e) { bi[e] = convb[cidx + e];
#pragma unroll
        for (int j = 0; j < 4; ++j) w[j][e] = convw[j * 768 + cidx + e]; }
}

__device__ __forceinline__ void vt_item(LAS unsigned char* lds_wave, unsigned char* ws, int item, int lane) {
    const int tt = item & 255, slab = (item >> 8) & 3, which = item >> 10; const int b = slab >> 1, g = slab & 1, r = lane & 15, quad = lane >> 4;
    const bf16_t* Pk = (const bf16_t*)(ws + WS_U) + ((size_t)b * T + (size_t)tt * 64) * PP + (which ? PC_KW : PC_KS) + 64 * g;
    const bf16_t* Pv = (const bf16_t*)(ws + WS_U) + ((size_t)b * T + (size_t)tt * 64) * PP + (which ? PC_VW : PC_VS) + 64 * g;
    LAS bf16_t* scr = (LAS bf16_t*)lds_wave;
#pragma unroll
    for (int rr = 0; rr < 8; ++rr) { const int t = 8 * rr + (lane >> 3), ck = lane & 7; const u32x4 v = *(const u32x4*)(Pv + (size_t)t * PP + 8 * ck);
        LAS unsigned* d = (LAS unsigned*)(scr + t * 66 + 8 * ck); d[0] = v.x; d[1] = v.y; d[2] = v.z; d[3] = v.w; }
    if (which) {
        bf16_t* KF = (bf16_t*)(ws + WS_KWF) + (size_t)slab * T * 64 + (size_t)tt * 4096;
        bf16_t* VF = (bf16_t*)(ws + WS_VWT) + (size_t)slab * T * 64 + (size_t)tt * 4096;
#pragma unroll
        for (int tl = 0; tl < 4; ++tl)
#pragma unroll
            for (int ks = 0; ks < 2; ++ks) { const u32x4 v = *(const u32x4*)(Pk + (size_t)(16 * tl + r) * PP + 32 * ks + 8 * quad); *(u32x4*)(KF + ((tl * 2 + ks) * 64 + lane) * 8) = v; }
        WAVE_SYNC();
#pragma unroll
        for (int gq = 0; gq < 2; ++gq)
#pragma unroll
            for (int dt = 0; dt < 4; ++dt) { const bf16x8 o = gather44(scr + (32 * gq + 4 * quad) * 66 + 16 * dt + r, 66); *(bf16x8*)(VF + ((gq * 4 + dt) * 64 + lane) * 8) = o; }
    } else {
        unsigned char* KF = ws + WS_KSF + (size_t)slab * T * 64 + (size_t)tt * 4096;
        unsigned char* VF = ws + WS_VST + (size_t)slab * T * 64 + (size_t)tt * 4096;
#pragma unroll
        for (int tl = 0; tl < 4; ++tl) { const bf16_t* kr = Pk + (size_t)(16 * tl + r) * PP + 8 * quad;
            const u32x2 a = bf8_to_fp8(*(const bf16x8*)kr, 1.f), c2 = bf8_to_fp8(*(const bf16x8*)(kr + 32), 1.f);
            u32x4 o; o.x = a.x; o.y = a.y; o.z = c2.x; o.w = c2.y; *(u32x4*)(KF + (tl * 64 + lane) * 16) = o; }
        WAVE_SYNC();
#pragma unroll
        for (int gq = 0; gq < 2; ++gq)
#pragma unroll
            for (int dp = 0; dp < 2; ++dp) { const u32x2 a = bf8_to_fp8(gather44(scr + (32 * gq + 4 * quad) * 66 + 16 * (2 * dp) + r, 66), 1.f), c2 = bf8_to_fp8(gather44(scr + (32 * gq + 4 * quad) * 66 + 16 * (2 * dp + 1) + r, 66), 1.f);
                u32x4 o; o.x = a.x; o.y = a.y; o.z = c2.x; o.w = c2.y; *(u32x4*)(VF + ((gq * 2 + dp) * 64 + lane) * 16) = o; }
    }
    WAVE_SYNC();
}

__device__ __forceinline__ void gmlp_item(LAS unsigned char* lds, unsigned char* ws, const float* lng, const float* lnb, const bf16_t* GW, const float* bs, int item, int tid) {
    const int lane = tid & 63, wv = tid >> 6, c = lane & 15, quad = lane >> 4;
    const int b = item >> 7, cc = item & 127; const size_t tok0 = (size_t)b * T + (size_t)cc * 128;
    const bf16_t* P = (const bf16_t*)(ws + WS_U); bf16_t* CAT = (bf16_t*)(ws + WS_H);
    LAS bf16_t* vN = (LAS bf16_t*)lds;
    constexpr int VS = 258;
    {   const f32x4 g4 = *(const f32x4*)(lng + 4 * lane), b4 = *(const f32x4*)(lnb + 4 * lane);
        for (int s0 = wv; s0 < 128; s0 += 16) {
            f32x4 v[2];
#pragma unroll
            for (int k = 0; k < 2; ++k) { const u32x2 raw = *(const u32x2*)(P + (tok0 + s0 + 8 * k) * PP + PC_V + 4 * lane);
                v[k].x = bf2f(raw.x & 0xffff); v[k].y = bf2f(raw.x >> 16); v[k].z = bf2f(raw.y & 0xffff); v[k].w = bf2f(raw.y >> 16); }
            float mean[2], rstd[2];
#pragma unroll
            for (int k = 0; k < 2; ++k) mean[k] = wave_fsum((v[k].x + v[k].y) + (v[k].z + v[k].w)) * (1.f / 256.f);
#pragma unroll
            for (int k = 0; k < 2; ++k) { v[k] = v[k] - mean[k]; rstd[k] = rsqrtf(wave_fsum((v[k].x * v[k].x + v[k].y * v[k].y) + (v[k].z * v[k].z + v[k].w * v[k].w)) * (1.f / 256.f) + LN_EPS); }
#pragma unroll
            for (int k = 0; k < 2; ++k) { const f32x4 o = v[k] * rstd[k] * g4 + b4;
                LAS unsigned* d = (LAS unsigned*)(vN + (s0 + 8 * k) * VS + 4 * lane); d[0] = pk2(o.x, o.y); d[1] = pk2(o.z, o.w); }
        }
    }
    __syncthreads();
    {   const int tt = wv, t = 16 * tt + c; const int nks = (16 * tt + 15) / 32 + 1;
        for (int grp = 0; grp < 4; ++grp) {
            f32x4 acc[4];
#pragma unroll
            for (int dt = 0; dt < 4; ++dt) acc[dt] = (f32x4){0.f, 0.f, 0.f, 0.f};
            const bf16_t* wrow = GW + ((size_t)grp * 128 + t) * 128 + 8 * quad;
            for (int ks = 0; ks < nks; ++ks) {
                const bf16x8 bw = *(const bf16x8*)(wrow + 32 * ks);
#pragma unroll
                for (int dt = 0; dt < 4; ++dt) { const bf16x8 av = gather8(vN + (32 * ks + 8 * quad) * VS + 64 * grp + 16 * dt + c, VS); acc[dt] = mfma16(av, bw, acc[dt]); }
            }
            const float bsv = bs[grp * 128 + t];
#pragma unroll
            for (int dt = 0; dt < 4; ++dt) { const int col = 64 * grp + 16 * dt + 4 * quad;
                const u32x2 raw = *(const u32x2*)(P + (tok0 + t) * PP + PC_U + col);
                f32x4 o; o.x = bf2f(raw.x & 0xffff) * (acc[dt].x + bsv); o.y = bf2f(raw.x >> 16) * (acc[dt].y + bsv); o.z = bf2f(raw.y & 0xffff) * (acc[dt].z + bsv); o.w = bf2f(raw.y >> 16) * (acc[dt].w + bsv);
                *(u32x2*)(CAT + (tok0 + t) * 1024 + 512 + col) = pk4(o); }
        }
    }
    __syncthreads();
}

__device__ __forceinline__ void ssd_s1_item(LAS unsigned char* lds, unsigned char* ws, const float* convw, const float* convb, const float* alog, int item, int tid) {
    const int lane = tid & 63, wv = tid >> 6, c = lane & 15, quad = lane >> 4;
    const int g = item & 1, ch = (item >> 1) & 63, b = item >> 7; const size_t tok0 = (size_t)b * T + (size_t)ch * 256;
    constexpr int RS = 258;
    LAS bf16_t* sm = (LAS bf16_t*)lds;
    LAS float* csl = (LAS float*)(lds + 256 * RS * 2);
    LAS float* dtl = csl + 512;
    const float* DT = (const float*)(ws + WS_DT); float* CS = (float*)(ws + WS_CS); float* CSL = (float*)(ws + WS_CSL);
    if (wv < 2) {
        const int h = 2 * g + wv; const float A = -__expf(alog[h]);
        float dv[4], cv[4]; float run = 0.f;
#pragma unroll
        for (int e = 0; e < 4; ++e) { dv[e] = DT[(tok0 + 4 * lane + e) * 4 + h]; run += A * dv[e]; cv[e] = run; }
        float incl = run;
#pragma unroll
        for (int o = 1; o < 64; o <<= 1) { const float y = __shfl_up(incl, o); if (lane >= o) incl += y; }
        const float excl = incl - run;
#pragma unroll
        for (int e = 0; e < 4; ++e) { const float cs = cv[e] + excl; csl[wv * 256 + 4 * lane + e] = cs; dtl[wv * 256 + 4 * lane + e] = dv[e]; CS[(tok0 + 4 * lane + e) * 4 + h] = cs; }
        if (lane == 63) CSL[((size_t)b * 64 + ch) * 4 + h] = incl;
    }
    __syncthreads();
    {   const bf16_t* P = (const bf16_t*)(ws + WS_U); const int oct = tid & 31; const bool isx = oct < 16;
        const int cidx = isx ? 128 * g + 8 * oct : 256 + 128 * g + 8 * (oct - 16); const int pcol = isx ? PC_X + 128 * g + 8 * oct : PC_B + 128 * g + 8 * (oct - 16);
        float w[4][8], bi[8]; load_convw(convw, convb, cidx, w, bi);
        const int hh = (oct >> 3) & 1; const float cl = csl[hh * 256 + 255];
        for (int l = tid >> 5; l < 256; l += 16) {
            float a[8]; conv_tok8(P + (tok0 + l) * PP + pcol, ch * 256 + l, w, bi, a);
            if (isx) { const float sc = dtl[hh * 256 + l] * __expf(cl - csl[hh * 256 + l]);
#pragma unroll
                for (int e = 0; e < 8; ++e) a[e] *= sc; }
            LAS unsigned* d = (LAS unsigned*)(sm + l * RS + 8 * oct); d[0] = pk2(a[0], a[1]); d[1] = pk2(a[2], a[3]); d[2] = pk2(a[4], a[5]); d[3] = pk2(a[6], a[7]);
        }
    }
    __syncthreads();
    {   const int hh = wv >> 2, nq = wv & 3;
        f32x4 acc[4][2];
#pragma unroll
        for (int mt = 0; mt < 4; ++mt) { acc[mt][0] = (f32x4){0.f, 0.f, 0.f, 0.f}; acc[mt][1] = (f32x4){0.f, 0.f, 0.f, 0.f}; }
        for (int ks = 0; ks < 8; ++ks) {
            const LAS bf16_t* rowb = sm + (32 * ks + 8 * quad) * RS;
            bf16x8 bfr[2];
#pragma unroll
            for (int nt = 0; nt < 2; ++nt) bfr[nt] = gather8(rowb + 128 + 32 * nq + 16 * nt + c, RS);
#pragma unroll
            for (int mt = 0; mt < 4; ++mt) { const bf16x8 af = gather8(rowb + hh * 64 + 16 * mt + c, RS);
                acc[mt][0] = mfma16(af, bfr[0], acc[mt][0]); acc[mt][1] = mfma16(af, bfr[1], acc[mt][1]); }
        }
        float* ST = (float*)(ws + WS_STATES) + (((size_t)b * 64 + ch) * 4 + 2 * g + hh) * 8192;
#pragma unroll
        for (int mt = 0; mt < 4; ++mt)
#pragma unroll
            for (int nt = 0; nt < 2; ++nt)
#pragma unroll
                for (int j = 0; j < 4; ++j) ST[(16 * mt + 4 * quad + j) * 128 + 32 * nq + 16 * nt + c] = acc[mt][nt][j];
    }
    __syncthreads();
}

__device__ __forceinline__ void ssd_s3_item(LAS unsigned char* lds, unsigned char* ws, const float* convw, const float* convb, const float* dskip, const float* normg, int item, int tid) {
    const int lane = tid & 63, wv = tid >> 6, c = lane & 15, quad = lane >> 4;
    const int g = item & 1, ch = (item >> 1) & 63, b = item >> 7; const size_t tok0 = (size_t)b * T + (size_t)ch * 256;
    constexpr int BS = 136, XS = 132;
    LAS bf16_t* Bc = (LAS bf16_t*)lds;
    LAS bf16_t* Xd = (LAS bf16_t*)(lds + 256 * BS * 2);
    LAS float* csl = (LAS float*)(lds + 256 * BS * 2 + 256 * XS * 2);
    LAS float* dtl = csl + 512;
    const float* DT = (const float*)(ws + WS_DT); const float* CS = (const float*)(ws + WS_CS);
    const bf16_t* P = (const bf16_t*)(ws + WS_U);
    {   const int hh = tid >> 8, l = tid & 255; csl[hh * 256 + l] = CS[(tok0 + l) * 4 + 2 * g + hh]; dtl[hh * 256 + l] = DT[(tok0 + l) * 4 + 2 * g + hh]; }
    LAS float* cwl = dtl + 512;
    for (int i = tid; i < 640; i += NTHREADS) { const int j = i >> 7, chn = i & 127; cwl[i] = j < 4 ? convw[j * 768 + 512 + 128 * g + chn] : convb[512 + 128 * g + chn]; }
    __syncthreads();
    {   const int oct = tid & 15;
        {   float w[4][8], bi[8]; load_convw(convw, convb, 256 + 128 * g + 8 * oct, w, bi);
            for (int s = tid >> 4; s < 256; s += 32) { float a[8]; conv_tok8(P + (tok0 + s) * PP + PC_B + 128 * g + 8 * oct, ch * 256 + s, w, bi, a);
                u32x4 pk; pk.x = pk2(a[0], a[1]); pk.y = pk2(a[2], a[3]); pk.z = pk2(a[4], a[5]); pk.w = pk2(a[6], a[7]);
                *(LAS u32x4*)(Bc + s * BS + 8 * oct) = pk; } }
        {   float w[4][8], bi[8]; load_convw(convw, convb, 128 * g + 8 * oct, w, bi); const int hh = oct >> 3;
            for (int s = tid >> 4; s < 256; s += 32) { float a[8]; conv_tok8(P + (tok0 + s) * PP + PC_X + 128 * g + 8 * oct, ch * 256 + s, w, bi, a);
                const float sc = dtl[hh * 256 + s];
                LAS u32x2* d = (LAS u32x2*)(Xd + s * XS + 8 * oct); u32x2 p0, p1; p0.x = pk2(a[0] * sc, a[1] * sc); p0.y = pk2(a[2] * sc, a[3] * sc); p1.x = pk2(a[4] * sc, a[5] * sc); p1.y = pk2(a[6] * sc, a[7] * sc);
                d[0] = p0; d[1] = p1; } }
    }
    __syncthreads();
    const bf16_t* PREV = (const bf16_t*)(ws + WS_PREV) + (((size_t)b * 64 + ch) * 4 + 2 * g) * 8192;
    bf16_t* CAT = (bf16_t*)(ws + WS_H);
    for (int lt = wv; lt < 16; lt += 8) {
        const int l0 = 16 * lt, l = l0 + c;
        bf16x8 cf[4];
#pragma unroll
        for (int ks = 0; ks < 4; ++ks) {
            float w[4][8], bi[8];
#pragma unroll
            for (int j = 0; j < 4; ++j) { const f32x4 a0 = *(const LAS f32x4*)(cwl + j * 128 + 32 * ks + 8 * quad), a1 = *(const LAS f32x4*)(cwl + j * 128 + 32 * ks + 8 * quad + 4);
                w[j][0] = a0.x; w[j][1] = a0.y; w[j][2] = a0.z; w[j][3] = a0.w; w[j][4] = a1.x; w[j][5] = a1.y; w[j][6] = a1.z; w[j][7] = a1.w; }
            { const f32x4 a0 = *(const LAS f32x4*)(cwl + 512 + 32 * ks + 8 * quad), a1 = *(const LAS f32x4*)(cwl + 512 + 32 * ks + 8 * quad + 4);
                bi[0] = a0.x; bi[1] = a0.y; bi[2] = a0.z; bi[3] = a0.w; bi[4] = a1.x; bi[5] = a1.y; bi[6] = a1.z; bi[7] = a1.w; }
            float a[8]; conv_tok8(P + (tok0 + l) * PP + PC_C + 128 * g + 32 * ks + 8 * quad, ch * 256 + l, w, bi, a);
            u32x4 pk; pk.x = pk2(a[0], a[1]); pk.y = pk2(a[2], a[3]); pk.z = pk2(a[4], a[5]); pk.w = pk2(a[6], a[7]);
            cf[ks] = __builtin_bit_cast(bf16x8, pk);
        }
        const float csl0 = csl[l], csl1 = csl[256 + l];
        f32x4 Y[2][4];
#pragma unroll
        for (int hh = 0; hh < 2; ++hh) { const float sc = __expf(hh ? csl1 : csl0);
#pragma unroll
            for (int pt = 0; pt < 4; ++pt) { f32x4 a = (f32x4){0.f, 0.f, 0.f, 0.f};
#pragma unroll
                for (int ks = 0; ks < 4; ++ks) { const bf16x8 pf = *(const bf16x8*)(PREV + (size_t)hh * 8192 + (16 * pt + c) * 128 + 32 * ks + 8 * quad); a = mfma16(pf, cf[ks], a); }
                Y[hh][pt] = a * sc; } }
        const int nsg = (l0 + 15) / 32 + 1;
        for (int sg = 0; sg < nsg; ++sg) {
            const int s0 = 32 * sg;
            f32x4 S0 = (f32x4){0.f, 0.f, 0.f, 0.f}, S1 = (f32x4){0.f, 0.f, 0.f, 0.f};
#pragma unroll
            for (int ks = 0; ks < 4; ++ks) { const bf16x8 b0 = *(const LAS bf16x8*)(Bc + (s0 + c) * BS + 32 * ks + 8 * quad), b1 = *(const LAS bf16x8*)(Bc + (s0 + 16 + c) * BS + 32 * ks + 8 * quad);
                S0 = mfma16(b0, cf[ks], S0); S1 = mfma16(b1, cf[ks], S1); }
#pragma unroll
            for (int hh = 0; hh < 2; ++hh) { const float cl = hh ? csl1 : csl0;
                f32x4 P0, P1;
#pragma unroll
                for (int j = 0; j < 4; ++j) { const int sa = s0 + 4 * quad + j, sb = sa + 16;
                    P0[j] = sa <= l ? S0[j] * __expf(cl - csl[hh * 256 + sa]) : 0.f; P1[j] = sb <= l ? S1[j] * __expf(cl - csl[hh * 256 + sb]) : 0.f; }
                const bf16x8 pf = pack8(P0, P1);
#pragma unroll
                for (int pt = 0; pt < 4; ++pt) { const bf16x8 xa = gather44(Xd + (s0 + 4 * quad) * XS + hh * 64 + 16 * pt + c, XS); Y[hh][pt] = mfma16(xa, pf, Y[hh][pt]); } }
        }
        float ss = 0.f;
#pragma unroll
        for (int hh = 0; hh < 2; ++hh) { const float dsk = dskip[2 * g + hh], idt = 1.f / dtl[hh * 256 + l];
#pragma unroll
            for (int pt = 0; pt < 4; ++pt) { const int chn = 128 * g + 64 * hh + 16 * pt + 4 * quad;
                const u32x2 zr = *(const u32x2*)(P + (tok0 + l) * PP + PC_Z + chn);
                const u32x2 xr = *(const LAS u32x2*)(Xd + l * XS + hh * 64 + 16 * pt + 4 * quad);
                const float zz[4] = {bf2f(zr.x & 0xffff), bf2f(zr.x >> 16), bf2f(zr.y & 0xffff), bf2f(zr.y >> 16)};
                const float xx[4] = {bf2f(xr.x & 0xffff), bf2f(xr.x >> 16), bf2f(xr.y & 0xffff), bf2f(xr.y >> 16)};
#pragma unroll
                for (int j = 0; j < 4; ++j) { const float y = (Y[hh][pt][j] + dsk * xx[j] * idt) * silu_f(zz[j]); Y[hh][pt][j] = y; ss += y * y; } } }
        ss = qsum(ss); const float rms = rsqrtf(ss * (1.f / 128.f) + LN_EPS);
#pragma unroll
        for (int hh = 0; hh < 2; ++hh)
#pragma unroll
            for (int pt = 0; pt < 4; ++pt) { const int chn = 128 * g + 64 * hh + 16 * pt + 4 * quad; const f32x4 ng = *(const f32x4*)(normg + chn);
                *(u32x2*)(CAT + (tok0 + l) * 1024 + 768 + chn) = pk4(Y[hh][pt] * rms * ng); }
    }
    __syncthreads();
}

__device__ __forceinline__ void attn_item(LAS unsigned char* lds, unsigned char* ws, int b, int g, int qt, int tid) {
    const int lane = tid & 63, wv = __builtin_amdgcn_readfirstlane(tid >> 6);
    const int slab = b * 2 + g, t0 = qt * 128 + 16 * wv;
    LAS float* imp = (LAS float*)(lds + wv * 17664);
    LAS int* sell = (LAS int*)(lds + wv * 17664 + 16384);
    LAS int* selc = sell + 256;
    const LAS float* lut = (const LAS float*)(lds + LDS_LUT) + (4 * g) * 128;
    const bf16_t* Qb = (const bf16_t*)(ws + WS_U); const float* GT = (const float*)(ws + WS_GATES);
    bf16_t* CAT = (bf16_t*)(ws + WS_H);
#define LANE_VIEW() int ln_ = lane; asm volatile("" : "+v"(ln_)); const int c = ln_ & 15, quad = ln_ >> 4, tq = t0 + c; const size_t tokq = (size_t)b * T + tq; (void)tq; (void)tokq; (void)quad
    for (int i = lane; i < 16 * 256; i += 64) imp[i] = 0.f;
    WAVE_SYNC();
#define LOAD_QF() float biasfar[4]; _Pragma("unroll") for (int i = 0; i < 4; ++i) biasfar[i] = lut[i * 128 + 127]; bf16x8 qf[4][2]; _Pragma("unroll") for (int i = 0; i < 4; ++i) _Pragma("unroll") for (int ks = 0; ks < 2; ++ks) qf[i][ks] = *(const bf16x8*)(Qb + tokq * PP + (4 * g + i) * 64 + 32 * ks + 8 * quad)
    f32x4 O[4][4];
#if EN_CMP
    {
        LANE_VIEW(); LOAD_QF();
        const bf16_t* KC = (const bf16_t*)(ws + WS_KCMP) + (size_t)slab * 1024 * 64 + ln_ * 8; const bf16_t* VCT = (const bf16_t*)(ws + WS_VCMPT) + (size_t)slab * 64 * 1024 + ln_ * 8;
        const int ngrp = t0 >= 16 ? ((t0 / 16 - 1) / 32 + 1) : 0;
        float m[4], l[4];
#pragma unroll
        for (int i = 0; i < 4; ++i) { m[i] = -1e30f; l[i] = 0.f; }
#define CMP_LOADK(kf, grp_) do { const bf16_t* kp_ = KC + (size_t)(grp_) * 2048; _Pragma("unroll") for (int tl = 0; tl < 2; ++tl) _Pragma("unroll") for (int ks = 0; ks < 2; ++ks) kf[tl][ks] = *(const bf16x8*)(kp_ + (tl * 2 + ks) * 512); } while (0)
#define CMP_LOADV(vf, grp_) do { const bf16_t* vp_ = VCT + (size_t)(grp_) * 2048; _Pragma("unroll") for (int dt = 0; dt < 4; ++dt) vf[dt] = *(const bf16x8*)(vp_ + dt * 512); } while (0)
#define CMP_SCORES(kf, k0, i) f32x4 s[2]; _Pragma("unroll") for (int tl = 0; tl < 2; ++tl) { s[tl] = mfma16(kf[tl][0], qf[i][0], (f32x4){0.f, 0.f, 0.f, 0.f}); s[tl] = mfma16(kf[tl][1], qf[i][1], s[tl]); } \
            if (far) {   \
                _Pragma("unroll") for (int tl = 0; tl < 2; ++tl) _Pragma("unroll") for (int j = 0; j < 4; ++j) s[tl][j] = (s[tl][j] + biasfar[i]) * LOG2E; } \
            else { _Pragma("unroll") for (int tl = 0; tl < 2; ++tl) _Pragma("unroll") for (int j = 0; j < 4; ++j) { const int dist = tq - (16 * ((k0) + 16 * tl + 4 * quad + j) + 31); \
                const float bias = lut[i * 128 + min(max(dist, 0), 127)]; s[tl][j] = dist >= 0 ? (s[tl][j] + bias) * LOG2E : -INFINITY; } }
#define P1_COMPUTE(kf, grp_) do { const int k0 = 32 * (grp_); const bool far = (t0 - (16 * (k0 + 31) + 31)) >= 127; \
            _Pragma("unroll") for (int i = 0; i < 4; ++i) { CMP_SCORES(kf, k0, i) \
                float mx = fmaxf(fmaxf(fmaxf(s[0][0], s[0][1]), fmaxf(s[0][2], s[0][3])), fmaxf(fmaxf(s[1][0], s[1][1]), fmaxf(s[1][2], s[1][3]))); \
                mx = qmax(mx); const float mn = fmaxf(m[i], mx); float ps = 0.f; \
                _Pragma("unroll") for (int tl = 0; tl < 2; ++tl) _Pragma("unroll") for (int j = 0; j < 4; ++j) ps += __builtin_amdgcn_exp2f(s[tl][j] - mn); \
                ps = qsum(ps); l[i] = l[i] * __builtin_amdgcn_exp2f(m[i] - mn) + ps; m[i] = mn; } } while (0)
        {
            bf16x8 kA[2][2], kB[2][2];
            if (ngrp > 0) CMP_LOADK(kA, 0);
            for (int grp = 0; grp < ngrp; grp += 2) {
                CMP_LOADK(kB, min(grp + 1, ngrp - 1));
                P1_COMPUTE(kA, grp);
                if (grp + 1 >= ngrp) break;
                CMP_LOADK(kA, min(grp + 2, ngrp - 1));
                P1_COMPUTE(kB, grp + 1);
            }
        }
        float ml[4];
#pragma unroll
        for (int i = 0; i < 4; ++i) ml[i] = m[i] + __builtin_amdgcn_logf(fmaxf(l[i], 1e-30f));
#pragma unroll
        for (int i = 0; i < 4; ++i)
#pragma unroll
            for (int dt = 0; dt < 4; ++dt) O[i][dt] = (f32x4){0.f, 0.f, 0.f, 0.f};
#define P2_COMPUTE(kf, vf, grp_) do { const int k0 = 32 * (grp_); const bool far = (t0 - (16 * (k0 + 31) + 31)) >= 127; \
            float mainv[2] = {0.f, 0.f}, spill[2] = {0.f, 0.f}; \
            _Pragma("unroll") for (int i = 0; i < 4; ++i) { CMP_SCORES(kf, k0, i) \
                _Pragma("unroll") for (int tl = 0; tl < 2; ++tl) { _Pragma("unroll") for (int j = 0; j < 4; ++j) s[tl][j] = __builtin_amdgcn_exp2f(s[tl][j] - ml[i]); \
                    mainv[tl] += (s[tl][0] + s[tl][1]) + (s[tl][2] + 0.5f * s[tl][3]); spill[tl] += 0.5f * s[tl][3]; } \
                const bf16x8 pf = pack8(s[0], s[1]); \
                _Pragma("unroll") for (int dt = 0; dt < 4; ++dt) O[i][dt] = mfma16(vf[dt], pf, O[i][dt]); } \
            const int nb = k0 / 4 + quad; \
            imp[c * 256 + nb] += mainv[0]; imp[c * 256 + nb + 4] += mainv[1]; asm volatile("" ::: "memory"); __builtin_amdgcn_wave_barrier(); \
            imp[c * 256 + nb + 1] += spill[0]; asm volatile("" ::: "memory"); __builtin_amdgcn_wave_barrier(); \
            if (nb + 5 < 256) imp[c * 256 + nb + 5] += spill[1]; \
            asm volatile("" ::: "memory"); __builtin_amdgcn_wave_barrier(); } while (0)
        {
            bf16x8 kA[2][2], vA[4];
            for (int grp = 0; grp < ngrp; ++grp) {
                CMP_LOADK(kA, grp); CMP_LOADV(vA, grp);
                P2_COMPUTE(kA, vA, grp);
            }
        }
#undef CMP_LOADK
#undef CMP_LOADV
#undef CMP_SCORES
#undef P1_COMPUTE
#undef P2_COMPUTE
    }
#else
#pragma unroll
    for (int i = 0; i < 4; ++i)
#pragma unroll
        for (int dt = 0; dt < 4; ++dt) O[i][dt] = (f32x4){0.f, 0.f, 0.f, 0.f};
#endif
    WAVE_SYNC();
    {
        const int cur = t0 >> 6; const int nf = 1 + (cur >= 1 ? 1 : 0) + (cur >= 2 ? 1 : 0), nr = min(16 - nf, max(cur - 2, 0));
        if (lane < 16) { sell[lane * 16] = 0; if (cur >= 1) sell[lane * 16 + 1] = cur; if (cur >= 2) sell[lane * 16 + 2] = cur - 1; selc[lane] = nf + nr; }
        for (int qi = 0; qi < 16; qi += 2) {
            unsigned v0[4], v1[4];
#pragma unroll
            for (int r = 0; r < 4; ++r) { const int n = lane + 64 * r; const bool okn = (n >= 1 && n <= cur - 2);
                const unsigned x0 = (__builtin_bit_cast(unsigned, imp[qi * 256 + n]) & 0xFFFFFF00u) | (unsigned)(255 - n);
                const unsigned x1 = (__builtin_bit_cast(unsigned, imp[(qi + 1) * 256 + n]) & 0xFFFFFF00u) | (unsigned)(255 - n);
                v0[r] = okn ? x0 : 0u; v1[r] = okn ? x1 : 0u; }
            for (int round = 0; round < nr; ++round) {
                const unsigned b0 = wave_umax(max(max(v0[0], v0[1]), max(v0[2], v0[3])));
                const unsigned b1 = wave_umax(max(max(v1[0], v1[1]), max(v1[2], v1[3])));
                const int i0 = 255 - (int)(b0 & 0xFFu), i1 = 255 - (int)(b1 & 0xFFu);
                if (lane == 0) { sell[qi * 16 + nf + round] = i0; sell[(qi + 1) * 16 + nf + round] = i1; }
#pragma unroll
                for (int r = 0; r < 4; ++r) { if (i0 == lane + 64 * r) v0[r] = 0u; if (i1 == lane + 64 * r) v1[r] = 0u; }
            }
        }
    }
    WAVE_SYNC();
    {
        LANE_VIEW();
#pragma unroll
        for (int i = 0; i < 4; ++i) { const float g0 = GT[tokq * 24 + (4 * g + i) * 3 + 0];
#pragma unroll
            for (int dt = 0; dt < 4; ++dt) *(LAS f32x4*)(imp + c * 256 + i * 64 + 16 * dt + 4 * quad) = O[i][dt] * g0; }
    }
    WAVE_SYNC();
#if EN_SEL
    {
        LANE_VIEW();
        const unsigned char* KSu = ws + WS_KSF + (size_t)slab * T * 64;
        const unsigned char* VSTu = ws + WS_VST + (size_t)slab * T * 64;
        const unsigned koff = (unsigned)ln_ * 16u;
        const int hc = c & 3; const float bfar = lut[hc * 128 + 127];
        const bool tsel1 = (c & 4) != 0, tsel2 = (c & 8) != 0; const int ktl = 16 * (c >> 2) + 4 * quad;
        const bool r4t1 = __builtin_amdgcn_readfirstlane(DPP_ROR(ln_ & 15, 4)) == 4;
        for (int qi = 0; qi < 16; ++qi) {
            const int tqq = t0 + qi, cur = tqq >> 6; const size_t tk = (size_t)b * T + tqq;
            u32x2 qs[2];
#pragma unroll
            for (int ks = 0; ks < 2; ++ks) qs[ks] = bf8_to_fp8(*(const bf16x8*)(Qb + tk * PP + (4 * g + hc) * 64 + 32 * ks + 8 * quad), 8.f);
            const int cnt = __builtin_amdgcn_readfirstlane(selc[qi]);
            float m = -1e30f, l = 0.f; f32x4 Os[4];
#pragma unroll
            for (int dt = 0; dt < 4; ++dt) Os[dt] = (f32x4){0.f, 0.f, 0.f, 0.f};
            u32x4 kA[4], kB[4], vA[4];
#define SEL_LOADK(kf, n) do { const unsigned char* kp_ = KSu + (size_t)(n) * 4096 + koff; _Pragma("unroll") for (int tl = 0; tl < 4; ++tl) kf[tl] = *(const u32x4*)(kp_ + tl * 1024); } while (0)
#define SEL_LOADV(vf, n) do { const unsigned char* vp_ = VSTu + (size_t)(n) * 4096 + koff; _Pragma("unroll") for (int q4 = 0; q4 < 4; ++q4) vf[q4] = *(const u32x4*)(vp_ + q4 * 1024); } while (0)
#define SEL_COMPUTE(kf, vf, n) do { f32x4 s[4]; \
            _Pragma("unroll") for (int tl = 0; tl < 4; ++tl) { s[tl] = mfma8((u32x2){kf[tl].x, kf[tl].y}, qs[0], (f32x4){0.f, 0.f, 0.f, 0.f}); s[tl] = mfma8((u32x2){kf[tl].z, kf[tl].w}, qs[1], s[tl]); } \
              \
            f32x4 u; _Pragma("unroll") for (int j = 0; j < 4; ++j) { const float a_ = tsel1 ? s[1][j] : s[0][j], b_ = tsel1 ? s[3][j] : s[2][j]; u[j] = (tsel2 ? b_ : a_) * 0.125f; } \
            const int kb_ = 64 * (n) + ktl; \
            if ((n) >= cur - 2) { _Pragma("unroll") for (int j = 0; j < 4; ++j) { const int dist = tqq - (kb_ + j); \
                    const float bias = lut[hc * 128 + min(max(dist, 0), 127)]; u[j] = dist >= 0 ? (u[j] + bias) * LOG2E : -INFINITY; } } \
            else { _Pragma("unroll") for (int j = 0; j < 4; ++j) u[j] = (u[j] + bfar) * LOG2E; } \
            float mx = fmaxf(fmaxf(u[0], u[1]), fmaxf(u[2], u[3])); \
            mx = fmaxf(mx, __builtin_bit_cast(float, DPP_ROR(__builtin_bit_cast(int, mx), 4))); mx = fmaxf(mx, __builtin_bit_cast(float, DPP_ROR(__builtin_bit_cast(int, mx), 8))); mx = qmax(mx); \
            if (__builtin_amdgcn_ballot_w64(mx > m) != 0ull) { const float mn = fmaxf(m, mx), al = __builtin_amdgcn_exp2f(m - mn); l *= al; m = mn; \
                _Pragma("unroll") for (int dt = 0; dt < 4; ++dt) Os[dt] = Os[dt] * al; } \
            _Pragma("unroll") for (int j = 0; j < 4; ++j) u[j] = __builtin_amdgcn_exp2f(u[j] - m); \
            float ps = (u[0] + u[1]) + (u[2] + u[3]); \
            ps += __builtin_bit_cast(float, DPP_ROR(__builtin_bit_cast(int, ps), 4)); ps += __builtin_bit_cast(float, DPP_ROR(__builtin_bit_cast(int, ps), 8)); ps = qsum(ps); l += ps; \
            const unsigned p4 = pk_fp8x4(u[0], u[1], u[2], u[3]); \
            const unsigned ra = (unsigned)DPP_ROR(p4, 4), rb = (unsigned)DPP_ROR(p4, 8), rc = (unsigned)DPP_ROR(p4, 12); \
            const u32x2 pf0 = (u32x2){p4, r4t1 ? ra : rc}, pf1 = (u32x2){rb, r4t1 ? rc : ra}; \
            _Pragma("unroll") for (int dp = 0; dp < 2; ++dp) { \
                Os[2 * dp] = mfma8((u32x2){vf[dp].x, vf[dp].y}, pf0, Os[2 * dp]); Os[2 * dp + 1] = mfma8((u32x2){vf[dp].z, vf[dp].w}, pf0, Os[2 * dp + 1]); \
                Os[2 * dp] = mfma8((u32x2){vf[2 + dp].x, vf[2 + dp].y}, pf1, Os[2 * dp]); Os[2 * dp + 1] = mfma8((u32x2){vf[2 + dp].z, vf[2 + dp].w}, pf1, Os[2 * dp + 1]); } } while (0)
#ifndef SEL_REP
#define SEL_REP 0
#endif
#if SEL_REP
            for (int rep = 0; rep < 2; ++rep) {
#define SELIDX(e_) ((SEL_REP == 2 && rep == 1) ? (e_) : __builtin_amdgcn_readfirstlane(sell[qi * 16 + (e_)]))
#else
            {
#define SELIDX(e_) __builtin_amdgcn_readfirstlane(sell[qi * 16 + (e_)])
#endif
            if (cnt > 0) { const int n0 = SELIDX(0); SEL_LOADK(kA, n0); }
            for (int e = 0; e < cnt; e += 2) {
                const int nA = SELIDX(e);
                const int nB = SELIDX(min(e + 1, cnt - 1));
                SEL_LOADV(vA, nA); SEL_LOADK(kB, nB);
                SEL_COMPUTE(kA, vA, nA);
                if (e + 1 >= cnt) break;
                const int nC = SELIDX(min(e + 2, cnt - 1));
                SEL_LOADV(vA, nB); SEL_LOADK(kA, nC);
                SEL_COMPUTE(kB, vA, nB);
            }
#if SEL_REP
            if (rep == 0) { const float sc0 = GT[tk * 24 + (4 * g + hc) * 3 + 1] / fmaxf(l, 1e-30f);
                if (c < 4) {
#pragma unroll
                    for (int dt = 0; dt < 4; ++dt) { LAS f32x4* sp = (LAS f32x4*)(imp + qi * 256 + c * 64 + 16 * dt + 4 * quad); *sp = *sp + Os[dt] * sc0; } }
                m = -1e30f; l = 0.f;
#pragma unroll
                for (int dt = 0; dt < 4; ++dt) Os[dt] = (f32x4){0.f, 0.f, 0.f, 0.f};
            } else { l = 1e30f;
#pragma unroll
                for (int dt = 0; dt < 4; ++dt) Os[dt] = Os[dt] * 0.f; }
#endif
            }
#undef SEL_LOADK
#undef SEL_LOADV
#undef SEL_COMPUTE
            const float sc = GT[tk * 24 + (4 * g + hc) * 3 + 1] / fmaxf(l, 1e-30f);
            if (c < 4) {
#pragma unroll
                for (int dt = 0; dt < 4; ++dt) { LAS f32x4* sp = (LAS f32x4*)(imp + qi * 256 + c * 64 + 16 * dt + 4 * quad); *sp = *sp + Os[dt] * sc; }
            }
        }
    }
    WAVE_SYNC();
#endif
    float lw[4];
#if EN_WIN
    {
        LANE_VIEW(); LOAD_QF();
        const bf16_t* KW = (const bf16_t*)(ws + WS_KWF) + (size_t)slab * T * 64 + ln_ * 8; const bf16_t* VWT = (const bf16_t*)(ws + WS_VWT) + (size_t)slab * T * 64 + ln_ * 8;
        float m[4];
#pragma unroll
        for (int i = 0; i < 4; ++i) { m[i] = -1e30f; lw[i] = 0.f;
#pragma unroll
            for (int dt = 0; dt < 4; ++dt) O[i][dt] = (f32x4){0.f, 0.f, 0.f, 0.f}; }
        const int g0 = ((t0 - 511 > 0 ? t0 - 511 : 0) & ~31) >> 5, g1 = (t0 + 15) >> 5;
#define WIN_LOAD(kf, vf, grp_) do { const bf16_t* kp_ = KW + (size_t)(grp_) * 2048; const bf16_t* vp_ = VWT + (size_t)(grp_) * 2048; \
            _Pragma("unroll") for (int tl = 0; tl < 2; ++tl) _Pragma("unroll") for (int ks = 0; ks < 2; ++ks) kf[tl][ks] = *(const bf16x8*)(kp_ + (tl * 2 + ks) * 512); \
            _Pragma("unroll") for (int dt = 0; dt < 4; ++dt) vf[dt] = *(const bf16x8*)(vp_ + dt * 512); } while (0)
#define WIN_COMPUTE(kf, vf, grp_) do { const int k0 = 32 * (grp_); const bool inner = (t0 - (k0 + 31)) >= 127 && (t0 + 15 - k0) < 512;     \
            _Pragma("unroll") for (int i = 0; i < 4; ++i) { f32x4 s[2]; \
                _Pragma("unroll") for (int tl = 0; tl < 2; ++tl) { s[tl] = mfma16(kf[tl][0], qf[i][0], (f32x4){0.f, 0.f, 0.f, 0.f}); s[tl] = mfma16(kf[tl][1], qf[i][1], s[tl]); } \
                float mx = -INFINITY; \
                if (inner) { _Pragma("unroll") for (int tl = 0; tl < 2; ++tl) _Pragma("unroll") for (int j = 0; j < 4; ++j) { const float v = (s[tl][j] + biasfar[i]) * LOG2E; s[tl][j] = v; mx = fmaxf(mx, v); } } \
                else { _Pragma("unroll") for (int tl = 0; tl < 2; ++tl) _Pragma("unroll") for (int j = 0; j < 4; ++j) { const int dist = tq - (k0 + 16 * tl + 4 * quad + j); \
                    const float bias = lut[i * 128 + min(max(dist, 0), 127)]; \
                    const float v = (dist >= 0 && dist < 512) ? (s[tl][j] + bias) * LOG2E : -INFINITY; s[tl][j] = v; mx = fmaxf(mx, v); } } \
                mx = qmax(mx); const float mn = fmaxf(m[i], mx), al = __builtin_amdgcn_exp2f(m[i] - mn); float ps = 0.f; \
                _Pragma("unroll") for (int tl = 0; tl < 2; ++tl) _Pragma("unroll") for (int j = 0; j < 4; ++j) { const float p = __builtin_amdgcn_exp2f(s[tl][j] - mn); s[tl][j] = p; ps += p; } \
                ps = qsum(ps); lw[i] = lw[i] * al + ps; m[i] = mn; \
                const bf16x8 pf = pack8(s[0], s[1]); \
                _Pragma("unroll") for (int dt = 0; dt < 4; ++dt) O[i][dt] = mfma16(vf[dt], pf, O[i][dt] * al); } } while (0)
        {
            bf16x8 kA[2][2], kB[2][2], vA[4], vB[4];
            WIN_LOAD(kA, vA, g0);
            for (int grp = g0; grp <= g1; grp += 2) {
                WIN_LOAD(kB, vB, min(grp + 1, g1));
                WIN_COMPUTE(kA, vA, grp);
                if (grp + 1 > g1) break;
                WIN_LOAD(kA, vA, min(grp + 2, g1));
                WIN_COMPUTE(kB, vB, grp + 1);
            }
        }
#undef WIN_LOAD
#undef WIN_COMPUTE
    }
#else
#pragma unroll
    for (int i = 0; i < 4; ++i) { lw[i] = 1.f;
#pragma unroll
        for (int dt = 0; dt < 4; ++dt) O[i][dt] = (f32x4){0.f, 0.f, 0.f, 0.f}; }
#endif
    LANE_VIEW();
#pragma unroll
    for (int i = 0; i < 4; ++i) { const float sc = GT[tokq * 24 + (4 * g + i) * 3 + 2] / fmaxf(lw[i], 1e-30f);
#pragma unroll
        for (int dt = 0; dt < 4; ++dt) { const f32x4 st = *(const LAS f32x4*)(imp + c * 256 + i * 64 + 16 * dt + 4 * quad);
            *(u32x2*)(CAT + tokq * 1024 + (4 * g + i) * 64 + 16 * dt + 4 * quad) = pk4(st + O[i][dt] * sc); } }
    WAVE_SYNC();
}

__device__ __forceinline__ void grid_bar(unsigned* bar, unsigned k, unsigned G) {
    asm volatile("s_waitcnt vmcnt(0) lgkmcnt(0)" ::: "memory");
    __syncthreads();
    if (threadIdx.x == 0) {
        __builtin_amdgcn_fence(__ATOMIC_RELEASE, "agent");
        asm volatile("s_waitcnt vmcnt(0)" ::: "memory");
        if ((G & 7u) == 0u) {
            const unsigned g = blockIdx.x & 7u;
            const unsigned old = __hip_atomic_fetch_add(bar + 64 * g, 1u, __ATOMIC_RELAXED, __HIP_MEMORY_SCOPE_AGENT);
            if (old + 1u == k * (G >> 3)) {
                const unsigned old2 = __hip_atomic_fetch_add(bar + 64 * 8, 1u, __ATOMIC_RELAXED, __HIP_MEMORY_SCOPE_AGENT);
                if (old2 + 1u == k * 8u) {
#pragma unroll
                    for (int j = 0; j < 8; ++j) __hip_atomic_store(bar + 64 * (9 + j), k, __ATOMIC_RELAXED, __HIP_MEMORY_SCOPE_AGENT);
                }
            }
            while (__hip_atomic_load(bar + 64 * (9 + g), __ATOMIC_RELAXED, __HIP_MEMORY_SCOPE_AGENT) < k) __builtin_amdgcn_s_sleep(1);
        } else {
            __hip_atomic_fetch_add(bar, 1u, __ATOMIC_RELAXED, __HIP_MEMORY_SCOPE_AGENT);
            while (__hip_atomic_load(bar, __ATOMIC_RELAXED, __HIP_MEMORY_SCOPE_AGENT) < k * G) __builtin_amdgcn_s_sleep(1);
        }
        __builtin_amdgcn_fence(__ATOMIC_ACQUIRE, "agent");
        asm volatile("s_waitcnt vmcnt(0)" ::: "memory");
    }
    __syncthreads();
}
typedef const __attribute__((address_space(4))) Params* KP;
__device__ __forceinline__ KP kp_get() { KP k = (KP)__builtin_amdgcn_kernarg_segment_ptr(); asm volatile("" : "+s"(k)); return k; }
#define PIN(i) (kp_get()->in[i])
#define PWS (kp_get()->ws)
#define POUT (kp_get()->out)

__device__ __forceinline__ void phase_prep(LAS unsigned char* lds, int tid, int lane, int wv, int bid, int G) {
    asm volatile("" : "+v"(tid)); lane = tid & 63; wv = __builtin_amdgcn_readfirstlane(tid >> 6);
    const int gw = bid * NWAVES + wv, NGW = G * NWAVES;
    {
        LAS float* vl = (LAS float*)lds; LAS float* red = (LAS float*)(lds + 16384);
        for (int it = bid; it < 288 + 16; it += G) {
            unsigned char* ws = PWS;
            if (it < 288) {
                const int l = it / 144, n0 = (it % 144) * 64; const float* cvec = PIN(1);
                for (int k = tid; k < 2048; k += NTHREADS) { const float cv = cvec[k]; vl[k] = silu_f(cv); }
                __syncthreads();
                float* MOD = (float*)(ws + WS_MOD);
                gemv_item(vl, red, PIN(3) + (size_t)l * D * MODW, MODW, 1024, n0, PIN(4) + (size_t)l * MODW, MOD + (size_t)(l * 2) * MODW, MOD + (size_t)(l * 2 + 1) * MODW, tid);
            } else {
                const int r = it - 288, lj = r >> 2, n0 = (r & 3) * 64; const float* cmp_pe = PIN(12);
                for (int k = tid; k < 4096; k += NTHREADS) vl[k] = k < 2048 ? cmp_pe[(size_t)lj * 2048 + k] : 0.f;
                __syncthreads();
                float* PEB = (float*)(ws + WS_PEB);
                gemv_item(vl, red, PIN(13) + (size_t)lj * 2048 * 256, 256, 2048, n0, PIN(14) + (size_t)lj * 256, PEB + (size_t)lj * 256, nullptr, tid);
            }
        }
        __syncthreads();
        LAS float* scr = (LAS float*)(lds + wv * 8704);
        constexpr int I_UP = 4 * 16 * 176, I_DN = 4 * 44 * 32, I_IN = 2 * 16 * 96, I_OUT = 2 * 16 * 32, I_CW = 4 * 32 * 8;
        constexpr int I_TOT = I_UP + I_DN + I_IN + I_OUT + I_CW;
        const int pl = 8 * ((lane & 15) >> 2) + 4 * ((lane & 31) >> 4) + (lane & 3);
        for (int it = gw; it < I_TOT; it += NGW) {
            int r = it; unsigned char* ws = PWS;
            if (r < I_UP) { const int f = r / (16 * 176), q = r % (16 * 176), kb = q / 176, nb = q % 176; const int n = 32 * nb + pl;
                const int pn = n >> 8, bj = (n >> 7) & 1, j = n & 127; const float* colp = (bj ? PIN(8) : PIN(7)) + (size_t)f * D * FF + 128 * pn + j;
                transpose_item(colp, FF, D, (bf16_t*)(ws + WS_W13) + (size_t)f * FF2 * D, 64 * kb, 32 * nb, scr, lane); continue; }
            r -= I_UP;
            if (r < I_DN) { const int f = r / (44 * 32), q = r % (44 * 32), kb = q / 32, nb = q % 32; const float* colp = PIN(9) + (size_t)f * FF * D + 32 * nb + pl;
                transpose_item(colp, D, FF, (bf16_t*)(ws + WS_W2) + (size_t)f * D * FF, 64 * kb, 32 * nb, scr, lane); continue; }
            r -= I_DN;
            if (r < I_IN) { const int l = r / (16 * 96), q = r % (16 * 96), kb = q / 96, nb = q % 96; const int n = 32 * nb + pl;
                int sc = -1; if (n < 1280) sc = n; else if (n < 2816) sc = n + 24; else if (n < 2840) sc = n - 2816 + 1280; else if (n < 2844) sc = n;
                const float* colp = sc >= 0 ? PIN(10) + (size_t)l * D * DIN + sc : nullptr;
                transpose_item(colp, DIN, D, (bf16_t*)(ws + WS_WIN) + (size_t)l * DINP * D, 64 * kb, 32 * nb, scr, lane); continue; }
            r -= I_IN;
            if (r < I_OUT) { const int l = r / (16 * 32), q = r % (16 * 32), kb = q / 32, nb = q % 32; const float* colp = PIN(11) + (size_t)l * D * D + 32 * nb + pl;
                transpose_item(colp, D, D, (bf16_t*)(ws + WS_WOUT) + (size_t)l * D * D, 64 * kb, 32 * nb, scr, lane); continue; }
            r -= I_OUT;
            { const int lj = r / (32 * 8), q = r % (32 * 8), kb = q / 8, nb = q % 8; const float* colp = PIN(13) + (size_t)lj * 2048 * 256 + 32 * nb + pl;
                transpose_item(colp, 256, 2048, (bf16_t*)(ws + WS_CW1) + (size_t)lj * 256 * 2048, 64 * kb, 32 * nb, scr, lane); }
        }
        { bf16_t* GW = (bf16_t*)(PWS + WS_GW); const float* gws = PIN(18);
          for (int i = bid * NTHREADS + tid; i < 2 * 4 * 128 * 128; i += G * NTHREADS) { const int s = i & 127, t = (i >> 7) & 127; GW[i] = (bf16_t)(s <= t ? f2bf(gws[i]) : 0u); } }
    }
    {
        LAS float* lut = (LAS float*)(lds + LDS_LUT); const float* rel_bias = PIN(2);
        for (int i = tid; i < 8 * 128; i += NTHREADS) { const int h = i >> 7, d = i & 127; int bk;
            if (d < 16) bk = d; else { bk = 16 + (int)(logf((float)d / 16.f) / logf(8.f) * 16.f); bk = bk < 31 ? bk : 31; }
            lut[i] = rel_bias[bk * 8 + h]; }
    }
}

__device__ __forceinline__ void phase_m2(LAS unsigned char* lds, int l, int tid, int bid, int G) {
    asm volatile("" : "+v"(tid));
    unsigned char* ws = PWS;
    if (bid < 32) {
        pg8::Gemm gm{(const bf16_t*)(ws + WS_U) + PC_KC, (const bf16_t*)(ws + WS_CW1) + (size_t)(l * 2) * 256 * 2048, 2048, 16 * PP, 2048, PP * 2, 8, 16, (size_t)64, (size_t)256 * 2048}; pg8::StaticOrder S; S.init(8192, 256, 32, bid);
        EpiBf E{2, (bf16_t*)(ws + WS_HID), (const float*)(ws + WS_PEB) + (size_t)(l * 2) * 256, nullptr, nullptr}; pg8::gemm_phase<EpiBf>(lds, gm, S, E);
    } else {
        for (int it = bid - 32; it < 512; it += G - 32) {
            if (it < 256) {
#if EN_GMLP
                gmlp_item(lds, PWS, PIN(16) + l * 256, PIN(17) + l * 256, (const bf16_t*)(PWS + WS_GW) + (size_t)l * 4 * 128 * 128, PIN(19) + l * 512, it, tid);
#endif
            } else {
#if EN_SSD
                ssd_s1_item(lds, PWS, PIN(20) + (size_t)l * 4 * 768, PIN(21) + l * 768, PIN(23) + l * 4, it - 256, tid);
#endif
            }
        }
        __syncthreads();
        { const int wv = __builtin_amdgcn_readfirstlane(tid >> 6);
          for (int it = (bid - 32) * NWAVES + wv; it < 2048; it += (G - 32) * NWAVES) vt_item(lds + wv * 8704, PWS, it, tid & 63); }
    }
}

__device__ __forceinline__ void phase_m3(int l, int tid, int bid, int G) {
    asm volatile("" : "+v"(tid));
    unsigned char* ws = PWS; const int lane = tid & 63, wv = __builtin_amdgcn_readfirstlane(tid >> 6);
    const bf16_t* HID = (const bf16_t*)(ws + WS_HID); bf16_t* KCMP = (bf16_t*)(ws + WS_KCMP); bf16_t* VCMPT = (bf16_t*)(ws + WS_VCMPT); const float* cmp_w2 = PIN(15);
    for (int rq = bid * NWAVES + wv; rq < 2048; rq += G * NWAVES) {
        const int row0 = 4 * rq, j = row0 >> 12, slab = ((row0 >> 10) & 1) * 2 + ((row0 >> 11) & 1), d = lane;
        const float* w2 = cmp_w2 + (size_t)(l * 2 + j) * 256 * 64 + d; const bf16_t* hr = HID + (size_t)row0 * 256;
        float a[4] = {0.f, 0.f, 0.f, 0.f};
#pragma unroll 2
        for (int k0 = 0; k0 < 256; k0 += 8) {
            bf16x8 hv[4];
#pragma unroll
            for (int r = 0; r < 4; ++r) hv[r] = *(const bf16x8*)(hr + r * 256 + k0);
#pragma unroll
            for (int kk = 0; kk < 8; ++kk) { const float w = w2[(k0 + kk) * 64];
#pragma unroll
                for (int r = 0; r < 4; ++r) a[r] += bf2f((unsigned short)hv[r][kk]) * w; }
        }
#pragma unroll
        for (int r = 0; r < 4; ++r) { const int n = (row0 + r) & 1023; const float av = n < 1023 ? a[r] : 0.f;
            if (j == 0) KCMP[(size_t)slab * 65536 + (size_t)(((n >> 4) * 2 + (d >> 5)) * 64 + ((d >> 3) & 3) * 16 + (n & 15)) * 8 + (d & 7)] = (bf16_t)f2bf(av);
            else { const int w = n & 31, hi = w >> 4, qv = (w & 15) >> 2, e = (w & 3) + 4 * hi;
                VCMPT[(size_t)slab * 65536 + (size_t)(((n >> 5) * 4 + (d >> 4)) * 64 + qv * 16 + (d & 15)) * 8 + e] = (bf16_t)f2bf(av); } }
    }
#if EN_SSD
    const float* ST = (const float*)(ws + WS_STATES); bf16_t* PREV = (bf16_t*)(ws + WS_PREV); const float* CSL = (const float*)(ws + WS_CSL);
    for (int i = bid * NTHREADS + tid; i < 2 * 4 * 8192; i += G * NTHREADS) {
        const int e = i & 8191, h = (i >> 13) & 3, b = i >> 15; float hs = 0.f;
        for (int c0 = 0; c0 < 64; c0 += 8) {
            float sv[8], dc[8];
#pragma unroll
            for (int q = 0; q < 8; ++q) { sv[q] = ST[(((size_t)b * 64 + c0 + q) * 4 + h) * 8192 + e]; dc[q] = CSL[((size_t)b * 64 + c0 + q) * 4 + h]; }
#pragma unroll
            for (int q = 0; q < 8; ++q) { PREV[(((size_t)b * 64 + c0 + q) * 4 + h) * 8192 + e] = (bf16_t)f2bf(hs); hs = __expf(dc[q]) * hs + sv[q]; }
        }
    }
#endif
}

__device__ __forceinline__ void phase_m4(LAS unsigned char* lds, int l, int tid, int bid, int G) {
    asm volatile("" : "+v"(tid));
    const int x = bid & 7, idx = bid >> 3;
    if (G == 256) {
        const int bg = x >> 1, jj = (x & 1) * 32 + idx;
        attn_item(lds, PWS, bg >> 1, bg & 1, jj, tid);
        attn_item(lds, PWS, bg >> 1, bg & 1, 127 - jj, tid);
#if (REP_MASK & 16)
        attn_item(lds, PWS, bg >> 1, bg & 1, jj, tid);
        attn_item(lds, PWS, bg >> 1, bg & 1, 127 - jj, tid);
#endif
    } else {
        for (int it = bid; it < 512; it += G) attn_item(lds, PWS, it >> 8, (it >> 7) & 1, it & 127, tid);
    }
    __syncthreads();
#if EN_SSD
#if (REP_MASK & 32)
    for (int it = bid; it < 256; it += G) ssd_s3_item(lds, PWS, PIN(20) + (size_t)l * 4 * 768, PIN(21) + l * 768, PIN(24) + l * 4, PIN(25) + l * 256, it, tid);
#endif
    for (int it = bid; it < 256; it += G) ssd_s3_item(lds, PWS, PIN(20) + (size_t)l * 4 * 768, PIN(21) + l * 768, PIN(24) + l * 4, PIN(25) + l * 256, it, tid);
#endif
}

__global__ void __launch_bounds__(NTHREADS, 2) mega_fwd(Params p) {
    extern __shared__ __attribute__((aligned(16))) unsigned char lds_raw[];
    LAS unsigned char* lds = (LAS unsigned char*)lds_raw;
    cg::grid_group grid = cg::this_grid();
    const int tid = threadIdx.x, lane = tid & 63, wv = __builtin_amdgcn_readfirstlane(tid >> 6);
    const int G = gridDim.x, bid = blockIdx.x;
    unsigned nbar = 0;
#define GBAR() do { ++nbar; grid_bar((unsigned*)(PWS + WS_BAR), nbar, (unsigned)G); } while (0)

    phase_prep(lds, tid, lane, wv, bid, G);
#if (REP_MASK & 1)
    __syncthreads(); phase_prep(lds, tid, lane, wv, bid, G);
#endif
    GBAR();
    {   int t2 = tid; asm volatile("" : "+v"(t2)); const int lane = t2 & 63, wv = __builtin_amdgcn_readfirstlane(t2 >> 6);
        const float* x_in = PIN(0); const float* MOD = (const float*)(PWS + WS_MOD); bf16_t* Hb = (bf16_t*)(PWS + WS_H);
#pragma unroll 2
        for (int row = bid * NWAVES + wv; row < NT; row += G * NWAVES) { const float* mb = MOD + (size_t)(row >= T ? 1 : 0) * MODW; mod_row(x_in + (size_t)row * D, Hb + (size_t)row * D, mb, mb + D, lane); } }
    GBAR();

#pragma unroll 1
    for (int l = 0; l < 2; ++l) {
#pragma unroll 1
        for (int sub = 0; sub < 3; ++sub) {
            const int f = l * 2 + (sub >> 1);
            {
                unsigned char* ws = PWS; const bool mix = sub == 1;
                pg8::Gemm gm{(const bf16_t*)(ws + WS_H), mix ? (const bf16_t*)(ws + WS_WIN) + (size_t)l * DINP * D : (const bf16_t*)(ws + WS_W13) + (size_t)f * FF2 * D, D, D, D, 128, 1 << 30, 1 << 30, 0, 0};
                pg8::StaticOrder S; S.init(NT, mix ? DINP : FF2, G, bid);
                EpiBf E{mix ? 1 : 0, (bf16_t*)(ws + WS_U), PIN(22) + l * 4, (float*)(ws + WS_GATES), (float*)(ws + WS_DT)};
                pg8::gemm_phase<EpiBf>(lds, gm, S, E);
#if (REP_MASK & 2)
                pg8::gemm_phase<EpiBf>(lds, gm, S, E);
#endif
                }
            GBAR();
            if (sub == 1) {
                phase_m2(lds, l, tid, bid, G);
#if (REP_MASK & 4)
                __syncthreads(); phase_m2(lds, l, tid, bid, G);
#endif
                GBAR();
                phase_m3(l, tid, bid, G);
#if (REP_MASK & 8)
                phase_m3(l, tid, bid, G);
#endif
                GBAR();
                phase_m4(lds, l, tid, bid, G);
                GBAR();

            }
            {
                unsigned char* ws = PWS; const bool mix = sub == 1;
                pg8::Gemm gm{mix ? (const bf16_t*)(ws + WS_H) : (const bf16_t*)(ws + WS_U), mix ? (const bf16_t*)(ws + WS_WOUT) + (size_t)l * D * D : (const bf16_t*)(ws + WS_W2) + (size_t)f * D * FF,
                             mix ? D : FF, mix ? D : FF, mix ? D : FF, 128, 1 << 30, 1 << 30, 0, 0};
                pg8::StaticOrder S; S.init(NT, D, G, bid);
                EpiBf E{3, (bf16_t*)(ws + WS_Y), nullptr, nullptr, nullptr}; pg8::gemm_phase<EpiBf>(lds, gm, S, E); }
            GBAR();
            {
                int t2 = tid; asm volatile("" : "+v"(t2)); const int lane = t2 & 63, wv = __builtin_amdgcn_readfirstlane(t2 >> 6);
                float* out = POUT; const float* MOD = (const float*)(PWS + WS_MOD); bf16_t* Hb = (bf16_t*)(PWS + WS_H);
                const float* gam = PIN(5) + (size_t)(l * 3 + sub) * D; const float* bet = PIN(6) + (size_t)(l * 3 + sub) * D;
                const bool last = (l == 1 && sub == 2);
                const int nl = sub == 2 ? l + 1 : l, ns = sub == 2 ? 0 : sub + 1;
                const int NGW2 = G * NWAVES; const float* xin = (l == 0 && sub == 0) ? PIN(0) : (const float*)out; const bf16_t* Yb = (const bf16_t*)(PWS + WS_Y);
                const float* gate = MOD + (size_t)(l * 2) * MODW + sub * 3072 + 2048; const float wgt = sub == 1 ? 1.0f : 0.5f;
                for (int row = bid * NWAVES + wv; row < NT; row += 2 * NGW2) {
                    const int r1 = row + NGW2 < NT ? row + NGW2 : row;
                    const float* mb0 = MOD + (size_t)((last ? 0 : nl) * 2 + (row >= T ? 1 : 0)) * MODW + ns * 3072;
                    const float* mb1 = MOD + (size_t)((last ? 0 : nl) * 2 + (r1 >= T ? 1 : 0)) * MODW + ns * 3072;
                    ln_row2(xin + (size_t)row * D, xin + (size_t)r1 * D, Yb + (size_t)row * D, Yb + (size_t)r1 * D, gate + (row >= T ? MODW : 0), gate + (r1 >= T ? MODW : 0), wgt,
                            out + (size_t)row * D, out + (size_t)r1 * D, gam, bet,
                            last ? nullptr : Hb + (size_t)row * D, last ? nullptr : Hb + (size_t)r1 * D, mb0, mb0 + D, mb1, mb1 + D, lane);
                }
            }
            if (!(l == 1 && sub == 2)) GBAR();
#if (REP_MASK & 64)
            for (int rep = 0; rep < 5; ++rep) GBAR();
#endif
        }
    }
    grid.sync();
}

extern "C" void kernel_launch(void* const* d_in, const int* in_sizes, int n_in, void* d_out, int out_size, void* d_ws, size_t ws_size, hipStream_t stream) {
    static int grid = 0;
    if (grid == 0) {
        int dev = 0, cus = 0, per_cu = 0;
        hipGetDevice(&dev);
        hipDeviceGetAttribute(&cus, hipDeviceAttributeMultiprocessorCount, dev);
        hipFuncSetAttribute((const void*)mega_fwd, hipFuncAttributeMaxDynamicSharedMemorySize, LDS_BYTES);
        if (hipOccupancyMaxActiveBlocksPerMultiprocessor(&per_cu, (const void*)mega_fwd, NTHREADS, LDS_BYTES) != hipSuccess || per_cu < 1) { fprintf(stderr, "occupancy query failed (%d)\n", per_cu); per_cu = 1; }
        (void)hipGetLastError();
        grid = cus * per_cu;
        if (n_in != 26 || ws_size < WS_END) { fprintf(stderr, "kernel_launch: unexpected n_in %d / ws_size %zu\n", n_in, ws_size); grid = -1; }
    }
    if (grid < 0) return;
    Params p{};
    for (int i = 0; i < 26; ++i) p.in[i] = (const float*)d_in[i];
    p.out = (float*)d_out; p.ws = (unsigned char*)d_ws;
    (void)hipMemsetAsync((char*)d_ws + WS_BAR, 0, 8192, stream);
    void* args[] = {&p};
    hipError_t e = hipLaunchCooperativeKernel((const void*)mega_fwd, dim3(grid), dim3(NTHREADS), args, LDS_BYTES, stream);
    if (e != hipSuccess) fprintf(stderr, "cooperative launch failed: %s (grid %d)\n", hipGetErrorString(e), grid);
}
```
